# Optimizing an MI355X kernel written in HIP

```python
import jax, jax.numpy as jnp
from jax import lax
import numpy as np

D_MODEL = 1024
BATCH = 8
SEQ = 2048
DEPTH = 2

N_MIXERS = 2
SB_HEADS = 16
SB_HEAD_DIM = D_MODEL // SB_HEADS
Q_BLOCK = 128
D_RNN = (D_MODEL * 5) // 4
LRU_BLOCKS = 10
LRU_BLOCK_W = D_RNN // LRU_BLOCKS
CONV_W = 4
LRU_C = 8.0
D_FF = ((8 * D_MODEL // 3 + 127) // 128) * 128
N_SUB = 3
MACARON_W = 0.5
EPS = 1e-6
N_SB_LAYERS = (DEPTH + 1) // 2
N_LRU_LAYERS = DEPTH // 2

kernel_name = "hybrid_stickbreak_rglru_macaron_adaln"


def rmsnorm(x, g):
    xf = x.astype(jnp.float32)
    inv = lax.rsqrt(jnp.mean(xf * xf, axis=-1, keepdims=True) + EPS)
    return (xf * inv).astype(x.dtype) * g


def sublayer_input(x, g, mod_j):
    shift, scale, gate = mod_j[:, 0], mod_j[:, 1], mod_j[:, 2]
    h = rmsnorm(x, g) * (1 + scale[:, None, :]) + shift[:, None, :]
    return h, (1 + gate)[:, None, :]


def swiglu(h, w_gu, w_down):
    g, u = jnp.split(h @ w_gu, 2, axis=-1)
    return (jax.nn.silu(g) * u) @ w_down


def stick_breaking_attention(h, w_qkv, w_o):
    B, S, _ = h.shape
    qkv = (h @ w_qkv).reshape(B, S, 3, SB_HEADS, SB_HEAD_DIM)
    qkv = jnp.transpose(qkv, (2, 0, 3, 1, 4)).astype(jnp.float32)
    q = qkv[0] * (SB_HEAD_DIM ** -0.5)
    k, v = qkv[1], qkv[2]
    outs = []
    for blk in range(S // Q_BLOCK):
        t0 = blk * Q_BLOCK
        L = t0 + Q_BLOCK
        z = jnp.einsum('bhqd,bhkd->bhqk', q[:, :, t0:L], k[:, :, :L])
        t_idx = t0 + jnp.arange(Q_BLOCK)
        s_idx = jnp.arange(L)
        mask = s_idx[None, :] < t_idx[:, None]
        log_keep = jnp.where(mask, jax.nn.log_sigmoid(-z), 0.0)
        later = lax.cumsum(log_keep, axis=3, reverse=True) - log_keep
        w = jnp.where(mask, jnp.exp(jax.nn.log_sigmoid(z) + later), 0.0)
        outs.append(jnp.einsum('bhqk,bhkd->bhqd', w, v[:, :, :L]))
    o = jnp.concatenate(outs, axis=2)
    o = jnp.transpose(o, (0, 2, 1, 3)).reshape(B, S, D_MODEL).astype(h.dtype)
    return o @ w_o


def _lin_rec_combine(left, right):
    a1, b1 = left
    a2, b2 = right
    return a1 * a2, a2 * b1 + b2


def rglru_block(h, w_in, conv_w, conv_b, w_r, b_r, w_i, b_i, lam, w_out):
    B, S, _ = h.shape
    gate, xb = jnp.split(h @ w_in, 2, axis=-1)
    xp = jnp.pad(xb, ((0, 0), (CONV_W - 1, 0), (0, 0)))
    xc = conv_b + xp[:, 0:S] * conv_w[0]
    for tap in range(1, CONV_W):
        xc = xc + xp[:, tap:tap + S] * conv_w[tap]
    xblk = xc.reshape(B, S, LRU_BLOCKS, LRU_BLOCK_W)
    r = jax.nn.sigmoid(jnp.einsum('bsnk,nkj->bsnj', xblk, w_r).reshape(B, S, D_RNN) + b_r)
    i = jax.nn.sigmoid(jnp.einsum('bsnk,nkj->bsnj', xblk, w_i).reshape(B, S, D_RNN) + b_i)
    log_a = -LRU_C * r.astype(jnp.float32) * jax.nn.softplus(-lam.astype(jnp.float32))
    a = jnp.exp(log_a)
    b = jnp.sqrt(-jnp.expm1(2.0 * log_a)) * (i * xc).astype(jnp.float32)
    _, hs = lax.associative_scan(_lin_rec_combine, (a, b), axis=1)
    y = jax.nn.gelu(gate) * hs.astype(h.dtype)
    return y @ w_out


def setup_inputs(seed: int = 0) -> dict:
    key = jax.random.key(seed)
    ks = jax.random.split(key, 24)
    D = D_MODEL
    f32 = jnp.float32
    nrm = lambda k, shape, s: jax.random.normal(k, shape, f32) * s
    x = nrm(ks[0], (BATCH, SEQ, D), 1.0)
    c = nrm(ks[1], (BATCH, D), 1.0)
    mod_w = nrm(ks[2], (DEPTH, D, N_SUB * 3 * D), 0.2 * D ** -0.5)
    mod_b = nrm(ks[3], (DEPTH, N_SUB * 3 * D), 0.05)
    norm_g = 1.0 + nrm(ks[4], (DEPTH, N_SUB, D), 0.02)
    ffn_w_gu = nrm(ks[5], (DEPTH, 2, D, 2 * D_FF), D ** -0.5)
    ffn_w_down = nrm(ks[6], (DEPTH, 2, D_FF, D), D_FF ** -0.5)
    sb_w_qkv = nrm(ks[7], (N_SB_LAYERS, D, 3 * D), D ** -0.5)
    sb_w_o = nrm(ks[8], (N_SB_LAYERS, D, D), D ** -0.5)
    lru_w_in = nrm(ks[9], (N_LRU_LAYERS, D, 2 * D_RNN), D ** -0.5)
    lru_conv_w = nrm(ks[10], (N_LRU_LAYERS, CONV_W, D_RNN), CONV_W ** -0.5)
    lru_conv_b = nrm(ks[11], (N_LRU_LAYERS, D_RNN), 0.02)
    lru_w_r = nrm(ks[12], (N_LRU_LAYERS, LRU_BLOCKS, LRU_BLOCK_W, LRU_BLOCK_W), LRU_BLOCK_W ** -0.5)
    lru_b_r = nrm(ks[13], (N_LRU_LAYERS, D_RNN), 0.1)
    lru_w_i = nrm(ks[14], (N_LRU_LAYERS, LRU_BLOCKS, LRU_BLOCK_W, LRU_BLOCK_W), LRU_BLOCK_W ** -0.5)
    lru_b_i = nrm(ks[15], (N_LRU_LAYERS, D_RNN), 0.1)
    a_c = jax.random.uniform(ks[16], (N_LRU_LAYERS, D_RNN), f32, 0.9, 0.999)
    a0 = a_c ** (1.0 / LRU_C)
    lru_lambda = jnp.log(a0) - jnp.log1p(-a0)
    lru_w_out = nrm(ks[17], (N_LRU_LAYERS, D_RNN, D), D_RNN ** -0.5)
    final_norm_g = 1.0 + nrm(ks[18], (D,), 0.02)
    return {"x": x, "c": c, "mod_w": mod_w, "mod_b": mod_b, "norm_g": norm_g,
            "ffn_w_gu": ffn_w_gu, "ffn_w_down": ffn_w_down,
            "sb_w_qkv": sb_w_qkv, "sb_w_o": sb_w_o,
            "lru_w_in": lru_w_in, "lru_conv_w": lru_conv_w, "lru_conv_b": lru_conv_b,
            "lru_w_r": lru_w_r, "lru_b_r": lru_b_r, "lru_w_i": lru_w_i, "lru_b_i": lru_b_i,
            "lru_lambda": lru_lambda, "lru_w_out": lru_w_out, "final_norm_g": final_norm_g}


def reference(x, c, mod_w, mod_b, norm_g, ffn_w_gu, ffn_w_down, sb_w_qkv, sb_w_o,
              lru_w_in, lru_conv_w, lru_conv_b, lru_w_r, lru_b_r, lru_w_i, lru_b_i,
              lru_lambda, lru_w_out, final_norm_g):
    B = x.shape[0]
    c_act = jax.nn.silu(c)
    for layer in range(DEPTH):
        mod = (c_act @ mod_w[layer] + mod_b[layer]).reshape(B, N_SUB, 3, D_MODEL)
        h, g = sublayer_input(x, norm_g[layer, 0], mod[:, 0])
        x = x + MACARON_W * g * swiglu(h, ffn_w_gu[layer, 0], ffn_w_down[layer, 0])
        h, g = sublayer_input(x, norm_g[layer, 1], mod[:, 1])
        j = layer // N_MIXERS
        if layer % N_MIXERS == 0:
            y = stick_breaking_attention(h, sb_w_qkv[j], sb_w_o[j])
        else:
            y = rglru_block(h, lru_w_in[j], lru_conv_w[j], lru_conv_b[j], lru_w_r[j], lru_b_r[j],
                            lru_w_i[j], lru_b_i[j], lru_lambda[j], lru_w_out[j])
        x = x + g * y
        h, g = sublayer_input(x, norm_g[layer, 2], mod[:, 2])
        x = x + MACARON_W * g * swiglu(h, ffn_w_gu[layer, 1], ffn_w_down[layer, 1])
    return rmsnorm(x, final_norm_g)
```

```cpp
#include <hip/hip_runtime.h>
#include <hip/hip_bf16.h>
#include <cstdio>
#include <cstdint>
#include <cmath>

#ifndef MK_ONE_LAUNCH
#define MK_ONE_LAUNCH 1
#endif

constexpr int BATCH = 8, SEQ = 2048, D = 1024, M = BATCH * SEQ, FF = 2816, NGU = 2 * FF, NQKV = 3 * D, DR = 1280, NIN = 2 * DR, NMOD = 9 * D, NH = 16, HD = 64;
constexpr float RMS_EPS = 1e-6f;
constexpr float LOG2E = 1.4426950408889634f;

__device__ __forceinline__ int opaque_tid() { int t = threadIdx.x; asm volatile("" : "+v"(t)); return t; }


namespace pg8 {
#define PG8_LAS __attribute__((address_space(3)))
typedef unsigned short bf16_t;
typedef short bf16x8 __attribute__((ext_vector_type(8)));
typedef float f32x4 __attribute__((ext_vector_type(4)));
typedef unsigned u32x4 __attribute__((ext_vector_type(4)));
constexpr int BM = 256, BK = 64, HALF = 128, HTB = HALF * BK * 2  , STAGE_BYTES = 8 * HTB, NXCD = 8, WGM = 8;

__host__ __device__ __forceinline__ int lds_byte(int r, int c) { const int st = (r >> 4) * 2 + (c >> 5), rr = r & 15, cc = c & 31, ob = rr * 64 + cc * 2; return st * 1024 + (ob ^ (((ob >> 9) & 1) << 5)); }
__host__ __device__ __forceinline__ void stage_rc(int b, int& R, int& C) { const int st = b / 1024, sb = b % 1024, swz = sb ^ (((sb >> 9) & 1) << 5); R = (st >> 1) * 16 + swz / 64; C = (st & 1) * 32 + (swz % 64) / 2; }
__host__ __device__ __forceinline__ int perm32(int rho) { const int n = rho >> 4, i = rho & 15; return 8 * (i >> 2) + 4 * n + (i & 3); }

struct Unit { int pm, pn; };
struct Gemm { const bf16_t* A; const bf16_t* Bt; int M, N, K; };

struct StaticOrder {
    int nM, nN, nwg, G, c;
    __host__ __device__ void init(int M, int N, int G_, int c_) { nM = M / BM; nN = N / BM; nwg = nM * nN; G = G_; c = c_; }
    __host__ __device__ bool next(int i, Unit& u) const {
        const long L = (long)i * G + c; if (L >= nwg) return false;
        int wgid = (int)L; { const int q = nwg / NXCD, r = nwg % NXCD, xcd = wgid % NXCD, off = wgid / NXCD; wgid = (xcd < r ? xcd * (q + 1) : r * (q + 1) + (xcd - r) * q) + off; }
        const int nig = WGM * nN, gid = wgid / nig, fm = gid * WGM, gsz = (nM - fm) < WGM ? (nM - fm) : WGM;
        u.pm = fm + ((wgid % nig) % gsz); u.pn = (wgid % nig) / gsz; return true;
    }
    __device__ __forceinline__ void a_ready(const Unit&) const {}
    __device__ __forceinline__ void done(const Unit&) const {}
};

__device__ __forceinline__ unsigned cvt_pk_bf16(float lo, float hi) { unsigned r; asm volatile("v_cvt_pk_bf16_f32 %0, %1, %2" : "=v"(r) : "v"(lo), "v"(hi)); return r; }
typedef unsigned u32x2 __attribute__((ext_vector_type(2)));

struct EpiQKV {
    static constexpr bool PERM = true, AFTER_DRAIN = false;
    bf16_t* O; int ldc; int split_cols; size_t split_stride; float scale0;
    __device__ __forceinline__ void operator()(const f32x4 (&acc)[2][2][4][2], const Unit& u, int wr, int wc, int fr, int fq) const {
        const int row0 = u.pm * BM + wr * 64 + fr; int colt = u.pn * BM; bf16_t* base = O;
        float sc = 1.f; { const int t = colt / split_cols; base += (size_t)t * split_stride; colt -= t * split_cols; if (t == 0) sc = scale0; }
        const int col0 = colt + wc * 32 + 8 * fq;
#pragma unroll
        for (int ai = 0; ai < 2; ++ai)
#pragma unroll
            for (int m = 0; m < 4; ++m) { bf16_t* rowp = base + (size_t)(row0 + ai * HALF + m * 16) * ldc + col0;
#pragma unroll
                for (int bj = 0; bj < 2; ++bj) { f32x4 v0 = acc[ai][bj][m][0] * sc, v1 = acc[ai][bj][m][1] * sc;
                    u32x4 w; w.x = cvt_pk_bf16(v0[0], v0[1]); w.y = cvt_pk_bf16(v0[2], v0[3]); w.z = cvt_pk_bf16(v1[0], v1[1]); w.w = cvt_pk_bf16(v1[2], v1[3]);
                    *(u32x4*)(rowp + bj * HALF) = w; } }
    }
};

__device__ __forceinline__ float silu_mul(float g, float u) { return g * __builtin_amdgcn_rcpf(1.0f + __builtin_amdgcn_exp2f(-g * 1.4426950408889634f)) * u; }
struct EpiSwiglu {
    static constexpr bool PERM = true, AFTER_DRAIN = false;
    bf16_t* O; int ldc;
    __device__ __forceinline__ void operator()(const f32x4 (&acc)[2][2][4][2], const Unit& u, int wr, int wc, int fr, int fq) const {
        const int row0 = u.pm * BM + wr * 64 + fr, col0 = u.pn * HALF + wc * 32 + 8 * fq;
#pragma unroll
        for (int ai = 0; ai < 2; ++ai)
#pragma unroll
            for (int m = 0; m < 4; ++m) { bf16_t* rowp = O + (size_t)(row0 + ai * HALF + m * 16) * ldc + col0;
                const f32x4 g0 = acc[ai][0][m][0], g1 = acc[ai][0][m][1], u0 = acc[ai][1][m][0], u1 = acc[ai][1][m][1];
                u32x4 w;
                w.x = cvt_pk_bf16(silu_mul(g0[0], u0[0]), silu_mul(g0[1], u0[1])); w.y = cvt_pk_bf16(silu_mul(g0[2], u0[2]), silu_mul(g0[3], u0[3]));
                w.z = cvt_pk_bf16(silu_mul(g1[0], u1[0]), silu_mul(g1[1], u1[1])); w.w = cvt_pk_bf16(silu_mul(g1[2], u1[2]), silu_mul(g1[3], u1[3]));
                *(u32x4*)rowp = w; }
    }
};

struct EpiResid {
    static constexpr bool PERM = false, AFTER_DRAIN = false;
    const float* base; float* out; int ldc; const float* gate; int gstride; float mw;
    __device__ __forceinline__ void operator()(const f32x4 (&acc)[2][2][4][2], const Unit& u, int wr, int wc, int fr, int fq) const {
        const int row0 = u.pm * BM + wr * 64 + fr, col0 = u.pn * BM + wc * 32 + 4 * fq;
        const float* gp = gate + (size_t)(u.pm >> 3) * gstride + col0;
        f32x4 gv[2][2];
#pragma unroll
        for (int bj = 0; bj < 2; ++bj)
#pragma unroll
            for (int n = 0; n < 2; ++n) gv[bj][n] = (*(const f32x4*)(gp + bj * HALF + n * 16) + 1.0f) * mw;
#pragma unroll
        for (int ai = 0; ai < 2; ++ai)
#pragma unroll
            for (int m = 0; m < 4; ++m) { const size_t off = (size_t)(row0 + ai * HALF + m * 16) * ldc + col0;
#pragma unroll
                for (int bj = 0; bj < 2; ++bj)
#pragma unroll
                    for (int n = 0; n < 2; ++n) { const f32x4 bs = *(const f32x4*)(base + off + bj * HALF + n * 16); *(f32x4*)(out + off + bj * HALF + n * 16) = bs + gv[bj][n] * acc[ai][bj][m][n]; } }
    }
};

__device__ __forceinline__ float gelu_tanh(float x) { const float y = x * (1.5957691216057308f + 0.0713548162726f * x * x); return x * __builtin_amdgcn_rcpf(1.0f + __builtin_amdgcn_exp2f(-y * 1.4426950408889634f)); }
struct EpiLruIn {
    static constexpr bool PERM = false, AFTER_DRAIN = false;
    bf16_t* GG; float* XB; int ldc;
    __device__ __forceinline__ void operator()(const f32x4 (&acc)[2][2][4][2], const Unit& u, int wr, int wc, int fr, int fq) const {
        const int row0 = u.pm * BM + wr * 64 + fr;
        if (u.pn < 5) {
            const int col0 = u.pn * BM + wc * 32 + 4 * fq;
#pragma unroll
            for (int ai = 0; ai < 2; ++ai)
#pragma unroll
                for (int m = 0; m < 4; ++m) { bf16_t* rowp = GG + (size_t)(row0 + ai * HALF + m * 16) * ldc + col0;
#pragma unroll
                    for (int bj = 0; bj < 2; ++bj)
#pragma unroll
                        for (int n = 0; n < 2; ++n) { const f32x4 v = acc[ai][bj][m][n]; u32x2 w; w.x = cvt_pk_bf16(gelu_tanh(v[0]), gelu_tanh(v[1])); w.y = cvt_pk_bf16(gelu_tanh(v[2]), gelu_tanh(v[3]));
                            *(u32x2*)(rowp + bj * HALF + n * 16) = w; } }
        } else {
            const int col0 = (u.pn - 5) * BM + wc * 32 + 4 * fq;
#pragma unroll
            for (int ai = 0; ai < 2; ++ai)
#pragma unroll
                for (int m = 0; m < 4; ++m) { float* rowp = XB + (size_t)(row0 + ai * HALF + m * 16) * ldc + col0;
#pragma unroll
                    for (int bj = 0; bj < 2; ++bj)
#pragma unroll
                        for (int n = 0; n < 2; ++n) *(f32x4*)(rowp + bj * HALF + n * 16) = acc[ai][bj][m][n]; }
        }
    }
};

template <class Epi, class Sched, bool ALIGN_EPI = false, bool SP2 = false>
__device__ __forceinline__ void gemm_phase(PG8_LAS unsigned char* lds, const Gemm g, const Sched& S, const Epi& E) {
    const int tid = opaque_tid(), wid = __builtin_amdgcn_readfirstlane(tid >> 6), lane = tid & 63, wr = wid >> 2, wc = wid & 3, fr = lane & 15, fq = lane >> 4;
    const int K = g.K, nt = K / BK;
    unsigned voffA[2], voffB[2];
#pragma unroll
    for (int i = 0; i < 2; ++i) { int R, C; stage_rc(tid * 16 + i * 8192, R, C); const int Rb = Epi::PERM ? ((R & ~31) + perm32(R & 31)) : R;
        voffA[i] = (unsigned)(R * K + C) * 2u; voffB[i] = (unsigned)(Rb * K + C) * 2u; }
    const size_t kstep = (size_t)(BK * 2);
    const size_t hstep = (size_t)HALF * K * 2;
    const size_t tstep = 2 * hstep;
    const unsigned ldsw = (unsigned)wid * 1024u;
    const int aoff = lds_byte(wr * 64 + fr, fq * 8), boff = lds_byte(wc * 32 + fr, fq * 8);
#define PG8_SA(b, h) (((b) * 2 + (h)) * HTB)
#define PG8_SB(b, h) ((4 + (b) * 2 + (h)) * HTB)
#define PG8_STAGE(bufoff, gbase, voff) do { _Pragma("unroll") for (int _i = 0; _i < 2; ++_i) \
        __builtin_amdgcn_global_load_lds((const unsigned*)((const char*)(gbase) + (voff)[_i]), (PG8_LAS unsigned*)(lds + (bufoff) + ldsw + _i * 8192), 16, 0, 0); } while (0)
#define PG8_LDA(dst, b, h) do { _Pragma("unroll") for (int m = 0; m < 4; ++m) _Pragma("unroll") for (int k = 0; k < 2; ++k) dst[m][k] = *(const PG8_LAS bf16x8*)(lds + PG8_SA(b, h) + aoff + m * 2048 + k * 1024); } while (0)
#define PG8_LDB(dst, b, h) do { _Pragma("unroll") for (int n = 0; n < 2; ++n) _Pragma("unroll") for (int k = 0; k < 2; ++k) dst[n][k] = *(const PG8_LAS bf16x8*)(lds + PG8_SB(b, h) + boff + n * 2048 + k * 1024); } while (0)
#define PG8_MMA(ai, bj, At, Bt) do { __builtin_amdgcn_s_setprio(1); _Pragma("unroll") for (int m = 0; m < 4; ++m) _Pragma("unroll") for (int n = 0; n < 2; ++n) _Pragma("unroll") for (int k = 0; k < 2; ++k) \
        acc[ai][bj][m][n] = __builtin_amdgcn_mfma_f32_16x16x32_bf16(Bt[n][k], At[m][k], acc[ai][bj][m][n], 0, 0, 0); __builtin_amdgcn_s_setprio(0); } while (0)
#define PG8_WAIT_V(n) asm volatile("s_waitcnt vmcnt(" #n ")" ::: "memory")
#define PG8_WAIT_L(n) asm volatile("s_waitcnt lgkmcnt(" #n ")" ::: "memory")
#define PG8_BAR __builtin_amdgcn_s_barrier()
#define PG8_SCHED __builtin_amdgcn_sched_barrier(0)
    Unit cur, nxt; int ui = 0;
    if (!S.next(0, cur)) return;
    f32x4 acc[2][2][4][2];
#pragma unroll
    for (int a = 0; a < 2; ++a)
#pragma unroll
        for (int b = 0; b < 2; ++b)
#pragma unroll
            for (int m = 0; m < 4; ++m)
#pragma unroll
                for (int n = 0; n < 2; ++n) acc[a][b][m][n] = (f32x4){0.f, 0.f, 0.f, 0.f};
    bf16x8 At[4][2], B0[2][2], B1[2][2];
    const char* cA = (const char*)g.A + (size_t)cur.pm * tstep; const char* cB = (const char*)g.Bt + (size_t)cur.pn * tstep;
    S.a_ready(cur);
    if constexpr (SP2) {
        PG8_STAGE(PG8_SB(0, 0), cB, voffB); PG8_STAGE(PG8_SB(0, 1), cB + hstep, voffB); PG8_STAGE(PG8_SA(0, 0), cA, voffA); PG8_STAGE(PG8_SA(0, 1), cA + hstep, voffA);
        if (wr == 1) PG8_BAR;
        PG8_WAIT_V(2); PG8_BAR;
        PG8_STAGE(PG8_SB(1, 0), cB + kstep, voffB); PG8_STAGE(PG8_SA(1, 0), cA + kstep, voffA); PG8_STAGE(PG8_SB(1, 1), cB + hstep + kstep, voffB);
        PG8_WAIT_V(6); PG8_BAR;
    } else {
        PG8_STAGE(PG8_SB(0, 0), cB, voffB); PG8_STAGE(PG8_SA(0, 0), cA, voffA); PG8_STAGE(PG8_SB(0, 1), cB + hstep, voffB); PG8_STAGE(PG8_SA(0, 1), cA + hstep, voffA);
        if (wr == 1) PG8_BAR;
        PG8_WAIT_V(4); PG8_BAR;
        PG8_STAGE(PG8_SB(1, 0), cB + kstep, voffB); PG8_STAGE(PG8_SA(1, 0), cA + kstep, voffA); PG8_STAGE(PG8_SB(1, 1), cB + hstep + kstep, voffB);
        PG8_WAIT_V(6); PG8_BAR;
    }
    for (;;) {
        const bool has_next = S.next(ui + 1, nxt);
        const char* nA = has_next ? (const char*)g.A + (size_t)nxt.pm * tstep : cA; const char* nB = has_next ? (const char*)g.Bt + (size_t)nxt.pn * tstep : cB;
        for (int t = 0; t < nt; t += 2) {
            const bool last = (t == nt - 2);
            const char* a1 = cA + (size_t)(t + 1) * kstep;
            const char* a2 = last ? nA : cA + (size_t)(t + 2) * kstep; const char* b2 = last ? nB : cB + (size_t)(t + 2) * kstep;
            const char* a3 = a2 + kstep; const char* b3 = b2 + kstep;
            if (last && has_next) S.a_ready(nxt);
            if constexpr (SP2) {
            PG8_LDB(B0, 0, 0); PG8_LDB(B1, 0, 1); PG8_SCHED; PG8_LDA(At, 0, 0); PG8_STAGE(PG8_SA(1, 1), a1 + hstep, voffA);
            PG8_WAIT_V(8); PG8_WAIT_L(0); PG8_BAR; PG8_MMA(0, 0, At, B0); PG8_MMA(0, 1, At, B1); PG8_BAR; PG8_SCHED;
            PG8_LDA(At, 0, 1); PG8_STAGE(PG8_SB(0, 0), b2, voffB); PG8_STAGE(PG8_SB(0, 1), b2 + hstep, voffB); PG8_STAGE(PG8_SA(0, 0), a2, voffA);
            PG8_WAIT_V(8); PG8_WAIT_L(0); PG8_BAR; PG8_MMA(1, 0, At, B0); PG8_MMA(1, 1, At, B1); PG8_BAR; PG8_SCHED;
            PG8_LDB(B0, 1, 0); PG8_LDB(B1, 1, 1); PG8_SCHED; PG8_LDA(At, 1, 0); PG8_STAGE(PG8_SA(0, 1), a2 + hstep, voffA);
            PG8_WAIT_V(8); PG8_WAIT_L(0); PG8_BAR; PG8_MMA(0, 0, At, B0); PG8_MMA(0, 1, At, B1); PG8_BAR; PG8_SCHED;
            PG8_LDA(At, 1, 1); PG8_STAGE(PG8_SB(1, 0), b3, voffB); PG8_STAGE(PG8_SB(1, 1), b3 + hstep, voffB); PG8_STAGE(PG8_SA(1, 0), a3, voffA);
            PG8_WAIT_V(8); PG8_WAIT_L(0); PG8_BAR; PG8_MMA(1, 0, At, B0); PG8_MMA(1, 1, At, B1); PG8_BAR; PG8_SCHED;
            } else {
            PG8_LDB(B0, 0, 0); PG8_SCHED; PG8_LDA(At, 0, 0); PG8_STAGE(PG8_SA(1, 1), a1 + hstep, voffA);
            PG8_WAIT_L(8); PG8_BAR; PG8_WAIT_L(0); PG8_MMA(0, 0, At, B0); PG8_BAR; PG8_SCHED;
            PG8_LDB(B1, 0, 1); PG8_STAGE(PG8_SB(0, 0), b2, voffB);
            PG8_BAR; PG8_WAIT_L(0); PG8_MMA(0, 1, At, B1); PG8_BAR;
            PG8_LDA(At, 0, 1); PG8_STAGE(PG8_SA(0, 0), a2, voffA);
            PG8_BAR; PG8_WAIT_L(0); PG8_MMA(1, 0, At, B0); PG8_BAR; PG8_SCHED;
            PG8_STAGE(PG8_SB(0, 1), b2 + hstep, voffB);
            PG8_WAIT_V(6); PG8_BAR; PG8_MMA(1, 1, At, B1); PG8_BAR;
            PG8_LDB(B0, 1, 0); PG8_SCHED; PG8_LDA(At, 1, 0); PG8_STAGE(PG8_SA(0, 1), a2 + hstep, voffA);
            PG8_WAIT_L(8); PG8_BAR; PG8_WAIT_L(0); PG8_MMA(0, 0, At, B0); PG8_BAR; PG8_SCHED;
            PG8_LDB(B1, 1, 1); PG8_STAGE(PG8_SB(1, 0), b3, voffB);
            PG8_BAR; PG8_WAIT_L(0); PG8_MMA(0, 1, At, B1); PG8_BAR;
            PG8_LDA(At, 1, 1); PG8_STAGE(PG8_SA(1, 0), a3, voffA);
            PG8_BAR; PG8_WAIT_L(0); PG8_MMA(1, 0, At, B0); PG8_BAR; PG8_SCHED;
            PG8_STAGE(PG8_SB(1, 1), b3 + hstep, voffB);
            PG8_WAIT_V(6); PG8_BAR; PG8_MMA(1, 1, At, B1); PG8_BAR;
            }
        }
        if constexpr (ALIGN_EPI) { if (wr == 0) PG8_BAR; }
        if constexpr (!Epi::AFTER_DRAIN) { E(acc, cur, wr, wc, fr, fq); S.done(cur); }
        if (!has_next) break;
#pragma unroll
        for (int a = 0; a < 2; ++a)
#pragma unroll
            for (int b = 0; b < 2; ++b)
#pragma unroll
                for (int m = 0; m < 4; ++m)
#pragma unroll
                    for (int n = 0; n < 2; ++n) acc[a][b][m][n] = (f32x4){0.f, 0.f, 0.f, 0.f};
        cur = nxt; cA = nA; cB = nB; ++ui;
        if constexpr (ALIGN_EPI) { if (wr == 1) PG8_BAR; }
    }
    PG8_WAIT_V(0);
    if constexpr (!ALIGN_EPI) { if (wr == 0) PG8_BAR; }
    PG8_BAR;
    if constexpr (Epi::AFTER_DRAIN) { E.fused(acc, cur, wr, wc, fr, fq, lds, wid, lane); S.done(cur); }
#undef PG8_SA
#undef PG8_SB
#undef PG8_STAGE
#undef PG8_LDA
#undef PG8_LDB
#undef PG8_MMA
#undef PG8_WAIT_V
#undef PG8_WAIT_L
#undef PG8_BAR
#undef PG8_SCHED
}
}
namespace sba {
using bf16x8 = __attribute__((ext_vector_type(8))) short;
using s16x4 = __attribute__((ext_vector_type(4))) short;
using f32x16 = __attribute__((ext_vector_type(16))) float;
using u32x4 = __attribute__((ext_vector_type(4))) unsigned;
typedef unsigned short bf16;
constexpr int DM = 1024, KVBLK = 64, QBLK = 32, QB = 256, SLOTB = 8192;
constexpr int LDS_K = 0, LDS_V = 2 * SLOTB, LDS_OST = 4 * SLOTB, LDS_BYTES = LDS_OST + 8 * 4096;
__device__ __forceinline__ int crow(int r, int hi) { return (r & 3) + 8 * (r >> 2) + 4 * hi; }
__device__ __forceinline__ void glds16(const void* gsrc, unsigned lds_dst) { unsigned keep;
    asm volatile("s_mov_b32 %0, m0\n\ts_mov_b32 m0, %2\n\ts_nop 0\n\tglobal_load_lds_dwordx4 %1, off\n\ts_mov_b32 m0, %0" : "=&s"(keep) : "v"(gsrc), "s"(lds_dst) : "memory"); }
typedef float f32x2_t __attribute__((ext_vector_type(2))); typedef __bf16 bf16x2_t __attribute__((ext_vector_type(2)));
__device__ __forceinline__ unsigned cvtpk_s(float lo, float hi) { f32x2_t v = {lo, hi}; bf16x2_t b = __builtin_convertvector(v, bf16x2_t); return __builtin_bit_cast(unsigned, b); }
#define SBA_WAIT_BAR() asm volatile("s_waitcnt vmcnt(0) lgkmcnt(0)\n\ts_barrier" ::: "memory")
typedef __attribute__((address_space(3))) const char* lds_cptr;

__device__ __forceinline__ void qkt(f32x16& p0, f32x16& p1, lds_cptr Kslot, const bf16x8* qr, int r32, int hi) {
    lds_cptr kb = Kslot + hi * 1024 + r32 * 16;
    const f32x16 z = f32x16{};
#pragma unroll
    for (int d0 = 0; d0 < 4; ++d0) {
        const bf16x8 b0 = *(const __attribute__((address_space(3))) bf16x8*)(kb + d0 * 2048);
        const bf16x8 b1 = *(const __attribute__((address_space(3))) bf16x8*)(kb + d0 * 2048 + 512);
        if (d0 == 0) { p0 = __builtin_amdgcn_mfma_f32_32x32x16_bf16(b0, qr[0], z, 0, 0, 0); p1 = __builtin_amdgcn_mfma_f32_32x32x16_bf16(b1, qr[0], z, 0, 0, 0); }
        else { p0 = __builtin_amdgcn_mfma_f32_32x32x16_bf16(b0, qr[d0], p0, 0, 0, 0); p1 = __builtin_amdgcn_mfma_f32_32x32x16_bf16(b1, qr[d0], p1, 0, 0, 0); } }
}
__device__ __forceinline__ void pv(f32x16* o, int vb, bf16x8 pa0, bf16x8 pa1, bf16x8 pa2, bf16x8 pa3) {
#pragma unroll
    for (int d0 = 0; d0 < 2; ++d0) { s16x4 lo[4], hi[4];
#pragma unroll
        for (int ks = 0; ks < 4; ++ks) {
            asm volatile("ds_read_b64_tr_b16 %0,%1 offset:%c2" : "=&v"(lo[ks]) : "v"(vb), "i"(d0 * 4096 + ks * 1024) : "memory");
            asm volatile("ds_read_b64_tr_b16 %0,%1 offset:%c2" : "=&v"(hi[ks]) : "v"(vb), "i"(d0 * 4096 + ks * 1024 + 512) : "memory"); }
        asm volatile("s_waitcnt lgkmcnt(0)" ::: "memory"); __builtin_amdgcn_sched_barrier(0);
#define SBA_PK(k) (bf16x8){lo[k][0], lo[k][1], lo[k][2], lo[k][3], hi[k][0], hi[k][1], hi[k][2], hi[k][3]}
        o[d0] = __builtin_amdgcn_mfma_f32_32x32x16_bf16(pa0, SBA_PK(0), o[d0], 0, 0, 0);
        o[d0] = __builtin_amdgcn_mfma_f32_32x32x16_bf16(pa1, SBA_PK(1), o[d0], 0, 0, 0);
        o[d0] = __builtin_amdgcn_mfma_f32_32x32x16_bf16(pa2, SBA_PK(2), o[d0], 0, 0, 0);
        o[d0] = __builtin_amdgcn_mfma_f32_32x32x16_bf16(pa3, SBA_PK(3), o[d0], 0, 0, 0);
#undef SBA_PK
    }
}

__device__ __forceinline__ void sb_weights(f32x16& p0, f32x16& p1, float& carry, int hi, int qk, bool diag) {
    f32x16 k0v, k1v;
#pragma unroll
    for (int r = 0; r < 16; ++r) {
        const float e0 = __builtin_amdgcn_exp2f(__builtin_fminf(p0[r], 64.f)), e1 = __builtin_amdgcn_exp2f(__builtin_fminf(p1[r], 64.f));
        float kp0 = __builtin_amdgcn_rcpf(1.0f + e0), kp1 = __builtin_amdgcn_rcpf(1.0f + e1);
        float sg0 = e0 * kp0, sg1 = e1 * kp1;
        if (diag) { const int kk = crow(r, hi); if (kk >= qk) { kp0 = 1.f; sg0 = 0.f; } if (kk + 32 >= qk) { kp1 = 1.f; sg1 = 0.f; } }
        k0v[r] = kp0; k1v[r] = kp1; p0[r] = sg0; p1[r] = sg1;
    }
    float R = carry;
#define SBA_GROUP(P, KV, g) do { \
        const float q2 = KV[4 * (g) + 3], q1 = q2 * KV[4 * (g) + 2], q0 = q1 * KV[4 * (g) + 1], gp = q0 * KV[4 * (g)]; \
        const unsigned own = __float_as_uint(gp); auto rr = __builtin_amdgcn_permlane32_swap(own, own, false, false); \
        const float other = __uint_as_float(rr[0] ^ rr[1] ^ own), pairp = __uint_as_float(rr[0]) * __uint_as_float(rr[1]); \
        const float rin = hi ? R : R * other; \
        P[4 * (g) + 3] *= rin; P[4 * (g) + 2] *= rin * q2; P[4 * (g) + 1] *= rin * q1; P[4 * (g)] *= rin * q0; \
        R *= pairp; } while (0)
    SBA_GROUP(p1, k1v, 3); SBA_GROUP(p1, k1v, 2); SBA_GROUP(p1, k1v, 1); SBA_GROUP(p1, k1v, 0);
    SBA_GROUP(p0, k0v, 3); SBA_GROUP(p0, k0v, 2); SBA_GROUP(p0, k0v, 1); SBA_GROUP(p0, k0v, 0);
#undef SBA_GROUP
    carry = R;
}

__device__ __forceinline__ void attn_unit(int b, int h, int qb, const bf16* Q, const bf16* K, const bf16* V, bf16* O, __attribute__((address_space(3))) char* shm) {
    const int tid = opaque_tid(), lane = tid & 63, r32 = lane & 31, hi = lane >> 5; const int wid = __builtin_amdgcn_readfirstlane(tid >> 6);
    const long rowbase = (long)b * SEQ; const int q0 = qb * QB;
    const bf16* Qw = Q + (rowbase + q0 + wid * QBLK) * DM + h * HD;
    const bf16* Kh = K + rowbase * DM + h * HD, * Vh = V + rowbase * DM + h * HD;
    const unsigned lds0 = (unsigned)(uintptr_t)shm;
    const bf16* ksrc = Kh + (long)lane * DM + wid * 8;
    const bf16* vsrc = Vh + (long)(16 * (wid & 3) + (lane >> 2)) * DM + (wid >> 2) * 32 + (lane & 3) * 8;
    const unsigned kdst = lds0 + LDS_K + wid * 1024, vdst = lds0 + LDS_V + wid * 1024;
#define SBA_DMA_K(t, slot) glds16(ksrc + (long)(t) * KVBLK * DM, (unsigned)__builtin_amdgcn_readfirstlane(kdst + (slot)))
#define SBA_DMA_V(t, slot) glds16(vsrc + (long)(t) * KVBLK * DM, (unsigned)__builtin_amdgcn_readfirstlane(vdst + (slot)))
    const int vb0 = (int)(lds0 + LDS_V) + ((lane >> 4) & 1) * 32 + (lane & 3) * 8 + (4 * hi + ((lane & 15) >> 2)) * 64;
    const lds_cptr shm3 = (lds_cptr)shm;
    const int NT = (q0 + QB) / KVBLK;
    SBA_DMA_K(NT - 1, 0); SBA_DMA_V(NT - 1, 0);
    bf16x8 qr[4];
#pragma unroll
    for (int d0 = 0; d0 < 4; ++d0) qr[d0] = *reinterpret_cast<const bf16x8*>(&Qw[(long)r32 * DM + d0 * 16 + hi * 8]);
    f32x16 o[2]; o[0] = f32x16{}; o[1] = f32x16{};
    float carry = 1.0f;
    const int qw0 = q0 + wid * QBLK;
    int slot = 0;
    for (int t = NT - 1; t >= 0; --t) {
        SBA_WAIT_BAR();
        if (t > 0) { SBA_DMA_K(t - 1, slot ^ SLOTB); SBA_DMA_V(t - 1, slot ^ SLOTB); }
        if (64 * t <= qw0) {
            f32x16 p0, p1;
            qkt(p0, p1, shm3 + LDS_K + slot, qr, r32, hi);
            sb_weights(p0, p1, carry, hi, qw0 + r32 - 64 * t, 64 * t + 64 > qw0);
            u32x4 pw0, pw1, pw2, pw3;
            pw0 = (u32x4){cvtpk_s(p0[0], p0[1]), cvtpk_s(p0[2], p0[3]), cvtpk_s(p0[4], p0[5]), cvtpk_s(p0[6], p0[7])};
            pw1 = (u32x4){cvtpk_s(p0[8], p0[9]), cvtpk_s(p0[10], p0[11]), cvtpk_s(p0[12], p0[13]), cvtpk_s(p0[14], p0[15])};
            pw2 = (u32x4){cvtpk_s(p1[0], p1[1]), cvtpk_s(p1[2], p1[3]), cvtpk_s(p1[4], p1[5]), cvtpk_s(p1[6], p1[7])};
            pw3 = (u32x4){cvtpk_s(p1[8], p1[9]), cvtpk_s(p1[10], p1[11]), cvtpk_s(p1[12], p1[13]), cvtpk_s(p1[14], p1[15])};
            __builtin_amdgcn_sched_barrier(0);
            pv(o, vb0 + slot, __builtin_bit_cast(bf16x8, pw0), __builtin_bit_cast(bf16x8, pw1), __builtin_bit_cast(bf16x8, pw2), __builtin_bit_cast(bf16x8, pw3));
        }
        slot ^= SLOTB;
    }
    bf16* Ow = O + (rowbase + q0 + wid * QBLK) * DM + h * HD;
    { __attribute__((address_space(3))) bf16* stg = (__attribute__((address_space(3))) bf16*)(shm3 + LDS_OST) + wid * 2048;
#pragma unroll
      for (int r = 0; r < 16; ++r) { const int orow = crow(r, hi);
#pragma unroll
        for (int d0 = 0; d0 < 2; ++d0) { const unsigned pk = cvtpk_s(o[d0][r], 0.f); stg[orow * 64 + d0 * 32 + r32] = (bf16)(pk & 0xffffu); } }
      asm volatile("s_waitcnt lgkmcnt(0)" ::: "memory");
#pragma unroll
      for (int i = 0; i < 4; ++i) { const int row = i * 8 + (lane >> 3), ch = lane & 7; const u32x4 v = *(const __attribute__((address_space(3))) u32x4*)(stg + row * 64 + ch * 8); *(u32x4*)(Ow + (long)row * DM + ch * 8) = v; } }
    asm volatile("s_waitcnt lgkmcnt(0)\n\ts_barrier" ::: "memory");
#undef SBA_DMA_K
#undef SBA_DMA_V
}
#undef SBA_WAIT_BAR
}

#define GAS __attribute__((address_space(1)))
#define LAS __attribute__((address_space(3)))
typedef unsigned short bf16;
typedef unsigned v4u __attribute__((ext_vector_type(4)));
typedef unsigned v2u __attribute__((ext_vector_type(2)));
typedef float f32x4 __attribute__((ext_vector_type(4)));
typedef short bf16x8 __attribute__((ext_vector_type(8)));
typedef GAS unsigned gu32;
#define RLX_AGENT __ATOMIC_RELAXED, __HIP_MEMORY_SCOPE_AGENT
#define LDS_WAIT() asm volatile("s_waitcnt lgkmcnt(0)" ::: "memory")
#define VM_WAIT() asm volatile("s_waitcnt vmcnt(0)" ::: "memory")
constexpr int NWAVES = 8;

constexpr size_t MiB = 1u << 20;
constexpr size_t WS_CTL = 0, CTL_ZERO_BYTES = 1 * MiB;
constexpr size_t WS_MOD = 1 * MiB;
constexpr size_t WS_SA = 2 * MiB, WS_SB = 3 * MiB;
constexpr size_t WS_WGU = 4 * MiB;
constexpr size_t WS_WDN = 48 * MiB;
constexpr size_t WS_WQKV = 70 * MiB, WS_WO = 76 * MiB, WS_WIN = 78 * MiB, WS_WOUT = 83 * MiB, WS_WRI = 86 * MiB;
constexpr size_t WS_XN = 88 * MiB;
constexpr size_t WS_OV = 120 * MiB;
constexpr size_t WS_ACT = WS_OV, WS_QO = WS_OV, WS_K = WS_OV + 32 * MiB, WS_V = WS_OV + 64 * MiB, WS_GG = WS_OV, WS_XB = WS_OV + 40 * MiB;
constexpr size_t WS_END = 240 * MiB;
static_assert(WS_WGU + 4 * (size_t)NGU * D * 2 <= WS_WDN && WS_WDN + 4 * (size_t)D * FF * 2 <= WS_WQKV && WS_WQKV + (size_t)NQKV * D * 2 <= WS_WO && WS_WO + (size_t)D * D * 2 <= WS_WIN &&
              WS_WIN + (size_t)NIN * D * 2 <= WS_WOUT && WS_WOUT + (size_t)D * DR * 2 <= WS_WRI && WS_WRI + 10 * 256 * 128 * 2 <= WS_XN && WS_XN + (size_t)M * D * 2 <= WS_OV &&
              WS_ACT + (size_t)M * FF * 2 <= WS_END && WS_V + (size_t)M * D * 2 <= WS_END && WS_XB + (size_t)M * DR * 4 <= WS_END && WS_GG + (size_t)M * DR * 2 <= WS_XB, "d_ws map");
constexpr int CW_BAR = 4096;

constexpr int RING_OFF = 0, RING_BYTES = 131072;
constexpr int LDS_BYTES = 155648;
constexpr int MISC_OFF = LDS_BYTES - 256;

__device__ __forceinline__ unsigned f2bf(float f) { unsigned u = __builtin_bit_cast(unsigned, f); return (u + 0x7fffu + ((u >> 16) & 1u)) >> 16; }
__device__ __forceinline__ unsigned pk2(float lo, float hi) { return f2bf(lo) | (f2bf(hi) << 16); }
__device__ __forceinline__ float bf2f(unsigned short b) { return __builtin_bit_cast(float, (unsigned)b << 16); }

#define XB_TMO      128
#define XB_XCNT(j)  (256  + 64 * (j))
#define XB_XSUB(j)  (1280 + 64 * (j))
#define XB_XGEN(j)  (2304 + 64 * (j))
#define XB_TOP      3328
#define XB_TOPGEN   3392
#define XCD_BAR_WORDS 3456
#define XB_SPIN_CAP (1u << 18)
__device__ __forceinline__ unsigned xb_ld(unsigned* p)              { return __hip_atomic_load(p, __ATOMIC_RELAXED, __HIP_MEMORY_SCOPE_AGENT); }
__device__ __forceinline__ unsigned xb_add(unsigned* p, unsigned v) { return __hip_atomic_fetch_add(p, v, __ATOMIC_RELAXED, __HIP_MEMORY_SCOPE_AGENT); }
__device__ __forceinline__ unsigned xb_xcc_id() { return (unsigned)__builtin_amdgcn_s_getreg((3 << 11) | 20) & 0xFu; }
#define XB_SPIN(cond, bar) do { unsigned _sp = 0; while (cond) { __builtin_amdgcn_s_sleep(1); \
    if ((++_sp & 255u) == 0u) { if (xb_ld(&(bar)[XB_TMO])) break; if (_sp > XB_SPIN_CAP) { atomicAdd(&(bar)[XB_TMO], 1u); break; } } } } while (0)
struct XcdBarrier { unsigned* bar; unsigned x; volatile LAS unsigned* st; };
__device__ __forceinline__ XcdBarrier xcd_barrier_post(unsigned* bar, volatile LAS unsigned* st) {
    XcdBarrier b; b.bar = bar; b.x = xb_xcc_id(); b.st = st;
    if (threadIdx.x == 0) (void)xb_add(&bar[XB_XCNT(b.x)], 1u);
    return b;
}
__device__ __forceinline__ void xcd_barrier_complete(unsigned* bar, unsigned x, unsigned& nloc, unsigned& nx) {
    const unsigned G = gridDim.x * gridDim.y * gridDim.z;
    unsigned sum, cnt, mine, sp = 0u;
    for (;;) {
        sum = 0u; cnt = 0u; mine = 0u;
#pragma unroll
        for (unsigned j = 0; j < 16; ++j) { const unsigned c = xb_ld(&bar[XB_XCNT(j)]); sum += c; cnt += (c > 0u) ? 1u : 0u; mine = (j == x) ? c : mine; }
        if (sum == G) break;
        __builtin_amdgcn_s_sleep(1);
        if ((++sp & 255u) == 0u) { if (xb_ld(&bar[XB_TMO])) break; if (sp > XB_SPIN_CAP) { atomicAdd(&bar[XB_TMO], 1u); break; } }
    }
    nloc = mine > 0u ? mine : 1u; nx = cnt > 0u ? cnt : 1u;
}
__device__ __forceinline__ void xcd_barrier(const XcdBarrier& b) {
    asm volatile("s_waitcnt vmcnt(0)" ::: "memory");
    __syncthreads();
    if (threadIdx.x == 0) {
        GAS unsigned* barg = (GAS unsigned*)b.bar; asm volatile("" : "+s"(barg)); unsigned* bar = (unsigned*)barg;
        __builtin_amdgcn_s_waitcnt(0);
        unsigned nloc = b.st[0], nx = b.st[1];
        if (nloc == 0u) { xcd_barrier_complete(bar, b.x, nloc, nx); b.st[0] = nloc; b.st[1] = nx; }
        const unsigned old = xb_add(&bar[XB_XSUB(b.x)], 1u);
        const unsigned gen = old / nloc;
        if (old + 1u == (gen + 1u) * nloc) {
            __builtin_amdgcn_fence(__ATOMIC_RELEASE, "agent");
            asm volatile("s_waitcnt vmcnt(0)" ::: "memory");
            const unsigned og = xb_add(&bar[XB_TOP], 1u);
            const unsigned tg = og / nx;
            if (og + 1u == (tg + 1u) * nx) xb_add(&bar[XB_TOPGEN], 1u);
            else XB_SPIN(xb_ld(&bar[XB_TOPGEN]) == tg, bar);
            __builtin_amdgcn_fence(__ATOMIC_ACQUIRE, "agent");
            xb_add(&bar[XB_XGEN(b.x)], 1u);
            asm volatile("s_waitcnt vmcnt(0)" ::: "memory");
        } else {
            XB_SPIN(xb_ld(&bar[XB_XGEN(b.x)]) == gen, bar);
            __builtin_amdgcn_fence(__ATOMIC_ACQUIRE, "agent");
            asm volatile("s_waitcnt vmcnt(0)" ::: "memory");
        }
    }
    __syncthreads();
}

struct Args { const float* in[19]; float* out; unsigned char* ws; int ph_lo, ph_hi, use_bar, pad; };

__device__ __forceinline__ float wave_sum(float v) {
#pragma unroll
    for (int o = 1; o < 64; o <<= 1) v += __shfl_xor(v, o);
    return v;
}

__device__ __forceinline__ void tr_tile(const float* src, int lds_, bf16* dst, int ldd, LAS float* scr, int lane) {
#pragma unroll 8
    for (int i = 0; i < 32; ++i) { const int kk = 2 * i + (lane >> 5); scr[kk * 33 + (lane & 31)] = src[(size_t)kk * lds_ + (lane & 31)]; }
    LDS_WAIT(); asm volatile("" ::: "memory");
    const int c = lane & 7;
#pragma unroll
    for (int j = 0; j < 4; ++j) { const int n = (lane >> 3) + 8 * j; const LAS float* s = scr + (8 * c) * 33 + n;
        v4u o; o.x = pk2(s[0 * 33], s[1 * 33]); o.y = pk2(s[2 * 33], s[3 * 33]); o.z = pk2(s[4 * 33], s[5 * 33]); o.w = pk2(s[6 * 33], s[7 * 33]);
        *(GAS v4u*)(dst + (size_t)n * ldd + 8 * c) = o; }
    LDS_WAIT(); asm volatile("" ::: "memory");
}
__device__ __forceinline__ void tr_plain(const float* W, int K, int N, bf16* WT, LAS float* scr, int item, int lane) {
    const int nblk = N / 32, kb = item / nblk, nb = item % nblk, k0 = 64 * kb, n0 = 32 * nb;
    tr_tile(W + (size_t)k0 * N + n0, N, WT + (size_t)n0 * K + k0, K, scr, lane);
}
__device__ __forceinline__ void p0_prologue(const Args& a, unsigned char* ws, LAS unsigned char* lds, int vcu, int G, int tid, int lane, int wave) {
    LAS float* scr = (LAS float*)(lds + wave * 8448);
    const int gw = vcu * NWAVES + wave, NGW = G * NWAVES;
    constexpr int I_GU = (D / 64) * (NGU / 32), I_DN = (FF / 64) * (D / 32), I_QKV = (D / 64) * (NQKV / 32), I_O = (D / 64) * (D / 32), I_IN = (D / 64) * (NIN / 32), I_OUT = (DR / 64) * (D / 32), I_G = 2 * 4;
    constexpr int NITEMS = 4 * I_GU + 4 * I_DN + I_QKV + I_O + I_IN + I_OUT + 20 * I_G;
    for (int it = gw; it < NITEMS; it += NGW) {
        int r = it;
        if (r < 4 * I_GU) {
            const int mat = r / I_GU, item = r % I_GU; const int nblk = NGU / 32, kb = item / nblk, nb = item % nblk, k0 = 64 * kb, n0 = 32 * nb;
            const int isu = n0 >= FF ? 1 : 0, ff0 = n0 - isu * FF, L0 = (ff0 >> 7) * 256 + isu * 128 + (ff0 & 127);
            const float* W = a.in[5] + (size_t)mat * D * NGU; bf16* WT = (bf16*)(ws + WS_WGU) + (size_t)mat * NGU * D;
            tr_tile(W + (size_t)k0 * NGU + n0, NGU, WT + (size_t)L0 * D + k0, D, scr, lane); continue; }
        r -= 4 * I_GU;
        if (r < 4 * I_DN) { const int mat = r / I_DN; tr_plain(a.in[6] + (size_t)mat * FF * D, FF, D, (bf16*)(ws + WS_WDN) + (size_t)mat * D * FF, scr, r % I_DN, lane); continue; }
        r -= 4 * I_DN;
        if (r < I_QKV) { tr_plain(a.in[7], D, NQKV, (bf16*)(ws + WS_WQKV), scr, r, lane); continue; } r -= I_QKV;
        if (r < I_O) { tr_plain(a.in[8], D, D, (bf16*)(ws + WS_WO), scr, r, lane); continue; } r -= I_O;
        if (r < I_IN) { tr_plain(a.in[9], D, NIN, (bf16*)(ws + WS_WIN), scr, r, lane); continue; } r -= I_IN;
        if (r < I_OUT) { tr_plain(a.in[17], DR, D, (bf16*)(ws + WS_WOUT), scr, r, lane); continue; } r -= I_OUT;
        { const int mat = r / I_G, item = r % I_G, n = mat >> 1, isi = mat & 1;
          tr_plain((isi ? a.in[14] : a.in[12]) + (size_t)n * 128 * 128, 128, 128, (bf16*)(ws + WS_WRI) + (size_t)n * 256 * 128 + (size_t)isi * 128 * 128, scr, item, lane); }
    }
    __syncthreads();
    LAS float* ca = (LAS float*)lds;
    LAS float* part = (LAS float*)(lds + 32768);
    for (int i = tid; i < BATCH * D; i += NWAVES * 64) { const int b = i / D, k = i % D; const float c = a.in[1][i]; ca[k * 8 + b] = c * __builtin_amdgcn_rcpf(1.0f + __builtin_amdgcn_exp2f(-c * LOG2E)); }
    __syncthreads();
    float* MOD = (float*)(ws + WS_MOD);
    for (int ch = vcu; ch < 2 * NMOD / 72; ch += G) {
        const int g0 = ch * 72, l = g0 / NMOD, j0 = g0 % NMOD;
        const float* W = a.in[2] + (size_t)l * D * NMOD + j0;
        const int rs = lane / 18, cg = lane % 18;
        f32x4 acc[8];
#pragma unroll
        for (int b = 0; b < 8; ++b) acc[b] = (f32x4){0.f, 0.f, 0.f, 0.f};
        if (rs < 3) {
#pragma unroll 4
            for (int i = 0; i < 43; ++i) { const int kl = 3 * i + rs; if (kl < 128) { const int k = wave * 128 + kl;
                const f32x4 w = *(const f32x4*)(W + (size_t)k * NMOD + 4 * cg);
                const f32x4 c0 = *(const LAS f32x4*)(ca + k * 8), c1 = *(const LAS f32x4*)(ca + k * 8 + 4);
                acc[0] += w * c0[0]; acc[1] += w * c0[1]; acc[2] += w * c0[2]; acc[3] += w * c0[3]; acc[4] += w * c1[0]; acc[5] += w * c1[1]; acc[6] += w * c1[2]; acc[7] += w * c1[3]; } }
#pragma unroll
            for (int b = 0; b < 8; ++b) *(LAS f32x4*)(part + ((wave * 3 + rs) * 8 + b) * 72 + 4 * cg) = acc[b];
        }
        __syncthreads();
        for (int o = tid; o < 8 * 72; o += NWAVES * 64) { const int b = o / 72, j = o % 72; float s = a.in[3][(size_t)l * NMOD + j0 + j];
#pragma unroll
            for (int p = 0; p < 24; ++p) s += part[(p * 8 + b) * 72 + j];
            MOD[((size_t)l * BATCH + b) * NMOD + j0 + j] = s; }
        __syncthreads();
    }
}

__device__ __forceinline__ void norm_mod_phase(const float* x, const float* g, const float* shift, const float* scale, bf16* XN, int vcu, int G, int lane, int wave) {
    const int gw = vcu * NWAVES + wave, NGW = G * NWAVES;
    for (int blk = gw; blk < M / 8; blk += NGW) {
        const int row0 = blk * 8, b = row0 / SEQ;
        f32x4 gs[4], sh[4];
#pragma unroll
        for (int j = 0; j < 4; ++j) { const int c = 4 * lane + 256 * j; gs[j] = *(const f32x4*)(g + c) * (*(const f32x4*)(scale + (size_t)b * NMOD + c) + 1.0f); sh[j] = *(const f32x4*)(shift + (size_t)b * NMOD + c); }
#pragma unroll 2
        for (int r = 0; r < 8; ++r) {
            const f32x4* xr = (const f32x4*)(x + (size_t)(row0 + r) * D) + lane;
            f32x4 v[4]; float s = 0.f;
#pragma unroll
            for (int j = 0; j < 4; ++j) { v[j] = xr[64 * j]; s += (v[j].x * v[j].x + v[j].y * v[j].y) + (v[j].z * v[j].z + v[j].w * v[j].w); }
            const float inv = 1.0f / sqrtf(wave_sum(s) * (1.f / D) + RMS_EPS);
            v2u* o8 = (v2u*)(XN + (size_t)(row0 + r) * D) + lane;
#pragma unroll
            for (int j = 0; j < 4; ++j) { const f32x4 h = v[j] * inv * gs[j] + sh[j]; v2u w; w.x = pk2(h.x, h.y); w.y = pk2(h.z, h.w); o8[64 * j] = w; }
        }
    }
}
__device__ __forceinline__ void final_norm_phase(const float* x, const float* g, float* out, int vcu, int G, int lane, int wave) {
    const int gw = vcu * NWAVES + wave, NGW = G * NWAVES;
    f32x4 gs[4];
#pragma unroll
    for (int j = 0; j < 4; ++j) gs[j] = *(const f32x4*)(g + 4 * lane + 256 * j);
    for (int row = gw; row < M; row += NGW) {
        const f32x4* xr = (const f32x4*)(x + (size_t)row * D) + lane;
        f32x4 v[4]; float s = 0.f;
#pragma unroll
        for (int j = 0; j < 4; ++j) { v[j] = xr[64 * j]; s += (v[j].x * v[j].x + v[j].y * v[j].y) + (v[j].z * v[j].z + v[j].w * v[j].w); }
        const float inv = 1.0f / sqrtf(wave_sum(s) * (1.f / D) + RMS_EPS);
        f32x4* o = (f32x4*)(out + (size_t)row * D) + lane;
#pragma unroll
        for (int j = 0; j < 4; ++j) o[64 * j] = v[j] * inv * gs[j];
    }
}

namespace lru {
constexpr int WSTR = 272;
constexpr int OFF_W = 0;
constexpr int OFF_XT = OFF_W + 256 * WSTR;
constexpr int OFF_AT = OFF_XT + 35 * 512;
constexpr int OFF_XC = OFF_AT + 32 * WSTR;
constexpr int OFF_A = OFF_XC + 32 * 512;
constexpr int OFF_B = OFF_A + 32 * 512;
constexpr int OFF_P = OFF_B + 32 * 512;
constexpr int LDS_END = OFF_P + 8 * 512;
static_assert(LDS_END <= MISC_OFF, "lru LDS map");
__device__ __forceinline__ float sigmoidf_(float x) { return __builtin_amdgcn_rcpf(1.0f + __builtin_amdgcn_exp2f(-x * LOG2E)); }

template <int PASS> __device__ __forceinline__ void lru_unit(const Args& a, unsigned char* ws, LAS unsigned char* lds, int chunk, int n, int tid, int lane, int wave) {
    const bf16* Wg = (const bf16*)(ws + WS_WRI) + (size_t)n * 256 * 128;
    float* XB = (float*)(ws + WS_XB); bf16* GG = (bf16*)(ws + WS_GG); float* SA = (float*)(ws + WS_SA); float* SB = (float*)(ws + WS_SB);
    LAS float* XT = (LAS float*)(lds + OFF_XT); LAS float* XC = (LAS float*)(lds + OFF_XC); LAS float* Aa = (LAS float*)(lds + OFF_A); LAS float* Bb = (LAS float*)(lds + OFF_B); LAS float* P = (LAS float*)(lds + OFF_P);
    for (int i = tid; i < 256 * 16; i += NWAVES * 64) { const int row = i >> 4, c16 = i & 15; *(LAS v4u*)(lds + OFF_W + row * WSTR + c16 * 16) = *(const v4u*)(Wg + row * 128 + c16 * 8); }
    if (tid < 128) { const int ch = n * 128 + tid;
        P[0 * 128 + tid] = a.in[10][0 * DR + ch]; P[1 * 128 + tid] = a.in[10][1 * DR + ch]; P[2 * 128 + tid] = a.in[10][2 * DR + ch]; P[3 * 128 + tid] = a.in[10][3 * DR + ch];
        P[4 * 128 + tid] = a.in[11][ch]; P[5 * 128 + tid] = a.in[13][ch]; P[6 * 128 + tid] = a.in[15][ch]; P[7 * 128 + tid] = 8.0f * log1pf(expf(-a.in[16][ch])); }
    float h = 0.f, Ac = 1.f;
    if (PASS == 2 && tid < 128) { const int cs = chunk & 15, c0 = chunk - cs;
        for (int c = 0; c < cs; ++c) { const size_t idx = (size_t)(c0 + c) * DR + n * 128 + tid; h = SA[idx] * h + SB[idx]; } }
    const int seq0 = (chunk >> 4) * SEQ;
    for (int sub = 0; sub < 4; ++sub) {
        const int r0 = chunk * 128 + sub * 32;
        for (int i = tid; i < 35 * 32; i += NWAVES * 64) { const int j = i >> 5, c4 = i & 31, grow = r0 - 3 + j;
            f32x4 v = (f32x4){0.f, 0.f, 0.f, 0.f}; if (grow >= seq0) v = *(const f32x4*)(XB + (size_t)grow * DR + n * 128 + 4 * c4);
            *(LAS f32x4*)(XT + j * 128 + 4 * c4) = v; }
        __syncthreads();
        { const int row = tid >> 4, c8 = (tid & 15) * 8; float xc[8];
#pragma unroll
          for (int e = 0; e < 8; ++e) { const int ch = c8 + e; float s = P[4 * 128 + ch];
#pragma unroll
              for (int tap = 0; tap < 4; ++tap) s += XT[(row + tap) * 128 + ch] * P[tap * 128 + ch];
              xc[e] = s; XC[row * 128 + ch] = s; }
          v4u o; o.x = pk2(xc[0], xc[1]); o.y = pk2(xc[2], xc[3]); o.z = pk2(xc[4], xc[5]); o.w = pk2(xc[6], xc[7]);
          *(LAS v4u*)(lds + OFF_AT + row * WSTR + c8 * 2) = o; }
        __syncthreads();
        { const int rg = wave & 1, cq = wave >> 1, fr = lane & 15, fq = lane >> 4;
          f32x4 acc[4];
#pragma unroll
          for (int t = 0; t < 4; ++t) acc[t] = (f32x4){0.f, 0.f, 0.f, 0.f};
#pragma unroll
          for (int ks = 0; ks < 4; ++ks) { const bf16x8 af = *(const LAS bf16x8*)(lds + OFF_AT + (16 * rg + fr) * WSTR + (32 * ks + 8 * fq) * 2);
#pragma unroll
              for (int t = 0; t < 4; ++t) { const int orow = (t >> 1) * 128 + 32 * cq + 16 * (t & 1) + fr; const bf16x8 bfg = *(const LAS bf16x8*)(lds + OFF_W + orow * WSTR + (32 * ks + 8 * fq) * 2);
                  acc[t] = __builtin_amdgcn_mfma_f32_16x16x32_bf16(bfg, af, acc[t], 0, 0, 0); } }
          const int row = 16 * rg + fr;
#pragma unroll
          for (int tt = 0; tt < 2; ++tt)
#pragma unroll
              for (int e = 0; e < 4; ++e) { const int ch = 32 * cq + 16 * tt + 4 * fq + e;
                  const float r = sigmoidf_(acc[tt][e] + P[5 * 128 + ch]), ig = sigmoidf_(acc[2 + tt][e] + P[6 * 128 + ch]);
                  const float la = -r * P[7 * 128 + ch], av = expf(la), bv = sqrtf(-expm1f(2.0f * la)) * (ig * XC[row * 128 + ch]);
                  Aa[row * 128 + ch] = av; Bb[row * 128 + ch] = bv; } }
        __syncthreads();
        if (tid < 128) {
#pragma unroll 8
            for (int r = 0; r < 32; ++r) { const float av = Aa[r * 128 + tid], bv = Bb[r * 128 + tid]; h = av * h + bv; Ac *= av; if (PASS == 2) Bb[r * 128 + tid] = h; } }
        if (PASS == 2) {
            __syncthreads();
            const int row = tid >> 4, c8 = (tid & 15) * 8; bf16* gp = GG + (size_t)(r0 + row) * DR + n * 128 + c8;
            const v4u gv = *(const v4u*)gp; const LAS float* hp = Bb + row * 128 + c8;
            v4u o;
            o.x = pk2(bf2f((unsigned short)(gv.x & 0xffffu)) * hp[0], bf2f((unsigned short)(gv.x >> 16)) * hp[1]); o.y = pk2(bf2f((unsigned short)(gv.y & 0xffffu)) * hp[2], bf2f((unsigned short)(gv.y >> 16)) * hp[3]);
            o.z = pk2(bf2f((unsigned short)(gv.z & 0xffffu)) * hp[4], bf2f((unsigned short)(gv.z >> 16)) * hp[5]); o.w = pk2(bf2f((unsigned short)(gv.w & 0xffffu)) * hp[6], bf2f((unsigned short)(gv.w >> 16)) * hp[7]);
            *(v4u*)gp = o;
        }
    }
    if (PASS == 1 && tid < 128) { const size_t idx = (size_t)chunk * DR + n * 128 + tid; SA[idx] = Ac; SB[idx] = h; }
    __syncthreads();
}
}

enum { PH_PROLOGUE = 0, PH_NORM, PH_GU, PH_DOWN, PH_QKV, PH_ATTN, PH_WO, PH_WIN, PH_LRU1, PH_LRU2, PH_WOUT, PH_FINAL };
constexpr int NPHASES = 23;
__constant__ unsigned char PH_KIND[NPHASES] = { PH_PROLOGUE,
    PH_NORM, PH_GU, PH_DOWN,  PH_NORM, PH_QKV, PH_ATTN, PH_WO,            PH_NORM, PH_GU, PH_DOWN,
    PH_NORM, PH_GU, PH_DOWN,  PH_NORM, PH_WIN, PH_LRU1, PH_LRU2, PH_WOUT, PH_NORM, PH_GU, PH_DOWN,
    PH_FINAL };
__constant__ unsigned char PH_LAYER[NPHASES] = { 0, 0,0,0, 0,0,0,0, 0,0,0, 1,1,1, 1,1,1,1,1, 1,1,1, 1 };
__constant__ unsigned char PH_SUB[NPHASES]   = { 0, 0,0,0, 1,1,1,1, 2,2,2, 0,0,0, 1,1,1,1,1, 2,2,2, 0 };

__global__ void __launch_bounds__(NWAVES * 64, 2) fwd_kernel(Args args) {
    extern __shared__ __attribute__((aligned(16))) unsigned char lds_raw[];
    LAS unsigned char* lds = (LAS unsigned char*)lds_raw;
    volatile LAS unsigned* MISC = (volatile LAS unsigned*)(lds + MISC_OFF);
    const int tid0 = threadIdx.x;
    const int G = gridDim.x; const int bx = blockIdx.x; const int vcu = (G % 8 == 0) ? (bx % 8) * (G / 8) + bx / 8 : bx;
    unsigned char* ws0 = args.ws;
    gu32* ctl = (gu32*)(ws0 + WS_CTL);
    for (int u = tid0; u < 64; u += NWAVES * 64) MISC[u] = 0u;
    __syncthreads();
    XcdBarrier bar; bar.bar = (unsigned*)(ctl + CW_BAR); bar.x = 0; bar.st = nullptr;
    if (args.use_bar) bar = xcd_barrier_post((unsigned*)(ctl + CW_BAR), MISC + 8);

    float* X = args.out;

    for (int ph = args.ph_lo; ph < args.ph_hi; ++ph) {
        int tid = tid0; asm volatile("" : "+v"(tid)); GAS unsigned char* wsg = (GAS unsigned char*)ws0; asm volatile("" : "+s"(wsg)); unsigned char* ws = (unsigned char*)wsg;
        const int lane = tid & 63, wave = __builtin_amdgcn_readfirstlane(tid >> 6);
        float* MOD = (float*)(ws + WS_MOD); bf16* XN = (bf16*)(ws + WS_XN);
        const int kind = PH_KIND[ph], l = PH_LAYER[ph], sub = PH_SUB[ph];
        const float* modl = MOD + (size_t)l * BATCH * NMOD + (size_t)sub * 3 * D;
        const int fidx = l * 2 + (sub == 2 ? 1 : 0);
        if (kind == PH_PROLOGUE) {
            p0_prologue(args, ws, lds, vcu, G, tid, lane, wave);
        } else if (kind == PH_NORM) {
            const float* xin = (ph == 1) ? args.in[0] : X;
            norm_mod_phase(xin, args.in[4] + (size_t)(l * 3 + sub) * D, modl, modl + D, XN, vcu, G, lane, wave);
        } else if (kind == PH_GU) {
            pg8::Gemm g{XN, (const bf16*)(ws + WS_WGU) + (size_t)fidx * NGU * D, M, NGU, D}; pg8::StaticOrder S; S.init(M, NGU, G, bx);
            pg8::EpiSwiglu E{(bf16*)(ws + WS_ACT), FF};
            pg8::gemm_phase<pg8::EpiSwiglu, pg8::StaticOrder, true, true>(lds + RING_OFF, g, S, E);
        } else if (kind == PH_DOWN || kind == PH_WO || kind == PH_WOUT) {
            const bf16* A; const bf16* Bt; int K; float mw;
            if (kind == PH_DOWN) { A = (const bf16*)(ws + WS_ACT); Bt = (const bf16*)(ws + WS_WDN) + (size_t)fidx * D * FF; K = FF; mw = 0.5f; }
            else if (kind == PH_WO) { A = (const bf16*)(ws + WS_QO); Bt = (const bf16*)(ws + WS_WO); K = D; mw = 1.0f; }
            else { A = (const bf16*)(ws + WS_GG); Bt = (const bf16*)(ws + WS_WOUT); K = DR; mw = 1.0f; }
            const float* base = (ph == 3) ? args.in[0] : X;
            pg8::Gemm g{A, Bt, M, D, K}; pg8::StaticOrder S; S.init(M, D, G, bx);
            pg8::EpiResid E{base, X, D, modl + 2 * D, NMOD, mw};
            pg8::gemm_phase<pg8::EpiResid, pg8::StaticOrder, true, true>(lds + RING_OFF, g, S, E);
        } else if (kind == PH_QKV) {
            pg8::Gemm g{XN, (const bf16*)(ws + WS_WQKV), M, NQKV, D}; pg8::StaticOrder S; S.init(M, NQKV, G, bx);
            pg8::EpiQKV E{(bf16*)(ws + WS_QO), D, D, (size_t)(WS_K - WS_QO) / 2, 0.125f * LOG2E};
            pg8::gemm_phase<pg8::EpiQKV, pg8::StaticOrder, true, true>(lds + RING_OFF, g, S, E);
        } else if (kind == PH_ATTN) {
            const sba::bf16* Qp = (const sba::bf16*)(ws + WS_QO); const sba::bf16* Kp = (const sba::bf16*)(ws + WS_K); const sba::bf16* Vp = (const sba::bf16*)(ws + WS_V);
            if (G == 256) {
                const int bh = vcu >> 1, hf = vcu & 1;
                for (int i = 0; i < 4; ++i) { const int qb = (i == 0) ? 7 - hf : (i == 1) ? hf : (i == 2) ? 5 - hf : 2 + hf;
                    sba::attn_unit(bh / NH, bh % NH, qb, Qp, Kp, Vp, (sba::bf16*)(ws + WS_QO), (LAS char*)(lds + RING_OFF)); }
            } else {
                for (int it = vcu; it < BATCH * NH * 8; it += G) sba::attn_unit((it >> 3) / NH, (it >> 3) % NH, it & 7, Qp, Kp, Vp, (sba::bf16*)(ws + WS_QO), (LAS char*)(lds + RING_OFF));
            }
        } else if (kind == PH_WIN) {
            pg8::Gemm g{XN, (const bf16*)(ws + WS_WIN), M, NIN, D}; pg8::StaticOrder S; S.init(M, NIN, G, bx);
            pg8::EpiLruIn E{(bf16*)(ws + WS_GG), (float*)(ws + WS_XB), DR};
            pg8::gemm_phase<pg8::EpiLruIn, pg8::StaticOrder, true, true>(lds + RING_OFF, g, S, E);
        } else if (kind == PH_LRU1) {
            for (int u = vcu; u < 1280; u += G) lru::lru_unit<1>(args, ws, lds, u & 127, u >> 7, tid, lane, wave);
        } else if (kind == PH_LRU2) {
            for (int u = vcu; u < 1280; u += G) lru::lru_unit<2>(args, ws, lds, u & 127, u >> 7, tid, lane, wave);
        } else {
            final_norm_phase(X, args.in[18], X, vcu, G, lane, wave);
        }
        if (ph + 1 < args.ph_hi) xcd_barrier(bar);
    }
}

extern "C" void kernel_launch(void* const* d_in, const int* in_sizes, int n_in, void* d_out, int out_size, void* d_ws, size_t ws_size, hipStream_t stream) {
    static int grid = 0;
    if (grid == 0) {
        if (n_in != 19 || in_sizes[0] != M * D || out_size != M * D || ws_size < WS_END) { fprintf(stderr, "kernel_launch: unexpected shapes (n_in %d, in0 %d, out %d, ws %zu); nothing launched\n", n_in, n_in > 0 ? in_sizes[0] : -1, out_size, ws_size); grid = -1; return; }
        int dev = 0, cus = 0, per_cu = 0;
        if (hipGetDevice(&dev) != hipSuccess || hipDeviceGetAttribute(&cus, hipDeviceAttributeMultiprocessorCount, dev) != hipSuccess) { fprintf(stderr, "kernel_launch: device query failed\n"); grid = -1; return; }
        if (hipFuncSetAttribute((const void*)fwd_kernel, hipFuncAttributeMaxDynamicSharedMemorySize, LDS_BYTES) != hipSuccess) { fprintf(stderr, "kernel_launch: hipFuncSetAttribute failed\n"); grid = -1; return; }
        if (hipOccupancyMaxActiveBlocksPerMultiprocessor(&per_cu, (const void*)fwd_kernel, NWAVES * 64, LDS_BYTES) != hipSuccess || per_cu < 1)
            fprintf(stderr, "kernel_launch: note: occupancy query reports %d workgroups per CU\n", per_cu);
        (void)hipGetLastError();
        grid = cus;
    }
    if (grid < 0) return;
    if (hipMemsetAsync((char*)d_ws + WS_CTL, 0, CTL_ZERO_BYTES, stream) != hipSuccess) { fprintf(stderr, "kernel_launch: hipMemsetAsync failed\n"); return; }
    Args a{};
    for (int i = 0; i < 19; ++i) a.in[i] = (const float*)d_in[i];
    a.out = (float*)d_out; a.ws = (unsigned char*)d_ws;
#if MK_ONE_LAUNCH
    a.ph_lo = 0; a.ph_hi = NPHASES; a.use_bar = 1;
    hipLaunchKernelGGL(fwd_kernel, dim3(grid), dim3(NWAVES * 64), LDS_BYTES, stream, a);
#else
    for (int ph = 0; ph < NPHASES; ++ph) { a.ph_lo = ph; a.ph_hi = ph + 1; a.use_bar = 0;
        hipLaunchKernelGGL(fwd_kernel, dim3(grid), dim3(NWAVES * 64), LDS_BYTES, stream, a); }
#endif
    const hipError_t le = hipPeekAtLastError();
    if (le != hipSuccess) fprintf(stderr, "kernel_launch: launch failed: %s\n", hipGetErrorName(le));
}
```

```cpp
#include <hip/hip_runtime.h>
#include <hip/hip_bf16.h>
#include <cstdio>
#include <cstdint>
#include <cmath>

#ifndef PROBE_DUP
#define PROBE_DUP 0
#endif
#ifndef MK_ONE_LAUNCH
#define MK_ONE_LAUNCH 1
#endif

constexpr int BATCH = 8, SEQ = 2048, D = 1024, M = BATCH * SEQ, FF = 2816, NGU = 2 * FF, NQKV = 3 * D, DR = 1280, NIN = 2 * DR, NMOD = 9 * D, NH = 16, HD = 64;
constexpr float RMS_EPS = 1e-6f;
constexpr float LOG2E = 1.4426950408889634f;

__device__ __forceinline__ int opaque_tid() { int t = threadIdx.x; asm volatile("" : "+v"(t)); return t; }


namespace pg8 {
#define PG8_LAS __attribute__((address_space(3)))
typedef unsigned short bf16_t;
typedef short bf16x8 __attribute__((ext_vector_type(8)));
typedef float f32x4 __attribute__((ext_vector_type(4)));
typedef unsigned u32x4 __attribute__((ext_vector_type(4)));
constexpr int BM = 256, BK = 64, HALF = 128, HTB = HALF * BK * 2  , STAGE_BYTES = 8 * HTB, NXCD = 8, WGM = 8;

__host__ __device__ __forceinline__ int lds_byte(int r, int c) { const int st = (r >> 4) * 2 + (c >> 5), rr = r & 15, cc = c & 31, ob = rr * 64 + cc * 2; return st * 1024 + (ob ^ (((ob >> 9) & 1) << 5)); }
__host__ __device__ __forceinline__ void stage_rc(int b, int& R, int& C) { const int st = b / 1024, sb = b % 1024, swz = sb ^ (((sb >> 9) & 1) << 5); R = (st >> 1) * 16 + swz / 64; C = (st & 1) * 32 + (swz % 64) / 2; }
__host__ __device__ __forceinline__ int perm32(int rho) { const int n = rho >> 4, i = rho & 15; return 8 * (i >> 2) + 4 * n + (i & 3); }

struct Unit { int pm, pn; };
struct Gemm { const bf16_t* A; const bf16_t* Bt; int M, N, K; };

struct StaticOrder {
    int nM, nN, nwg, G, c;
    __host__ __device__ void init(int M, int N, int G_, int c_) { nM = M / BM; nN = N / BM; nwg = nM * nN; G = G_; c = c_; }
    __host__ __device__ bool next(int i, Unit& u) const {
        const long L = (long)i * G + c; if (L >= nwg) return false;
        int wgid = (int)L; { const int q = nwg / NXCD, r = nwg % NXCD, xcd = wgid % NXCD, off = wgid / NXCD; wgid = (xcd < r ? xcd * (q + 1) : r * (q + 1) + (xcd - r) * q) + off; }
        const int nig = WGM * nN, gid = wgid / nig, fm = gid * WGM, gsz = (nM - fm) < WGM ? (nM - fm) : WGM;
        u.pm = fm + ((wgid % nig) % gsz); u.pn = (wgid % nig) / gsz; return true;
    }
    __device__ __forceinline__ void a_ready(const Unit&) const {}
    __device__ __forceinline__ void done(const Unit&) const {}
};

__device__ __forceinline__ unsigned cvt_pk_bf16(float lo, float hi) { unsigned r; asm volatile("v_cvt_pk_bf16_f32 %0, %1, %2" : "=v"(r) : "v"(lo), "v"(hi)); return r; }
typedef unsigned u32x2 __attribute__((ext_vector_type(2)));

struct EpiQKV {
    static constexpr bool PERM = true, AFTER_DRAIN = false;
    bf16_t* O; int ldc; int split_cols; size_t split_stride; float scale0;
    __device__ __forceinline__ void operator()(const f32x4 (&acc)[2][2][4][2], const Unit& u, int wr, int wc, int fr, int fq) const {
        const int row0 = u.pm * BM + wr * 64 + fr; int colt = u.pn * BM; bf16_t* base = O;
        float sc = 1.f; { const int t = colt / split_cols; base += (size_t)t * split_stride; colt -= t * split_cols; if (t == 0) sc = scale0; }
        const int col0 = colt + wc * 32 + 8 * fq;
#pragma unroll
        for (int ai = 0; ai < 2; ++ai)
#pragma unroll
            for (int m = 0; m < 4; ++m) { bf16_t* rowp = base + (size_t)(row0 + ai * HALF + m * 16) * ldc + col0;
#pragma unroll
                for (int bj = 0; bj < 2; ++bj) { f32x4 v0 = acc[ai][bj][m][0] * sc, v1 = acc[ai][bj][m][1] * sc;
                    u32x4 w; w.x = cvt_pk_bf16(v0[0], v0[1]); w.y = cvt_pk_bf16(v0[2], v0[3]); w.z = cvt_pk_bf16(v1[0], v1[1]); w.w = cvt_pk_bf16(v1[2], v1[3]);
                    *(u32x4*)(rowp + bj * HALF) = w; } }
    }
};

__device__ __forceinline__ float silu_mul(float g, float u) { return g * __builtin_amdgcn_rcpf(1.0f + __builtin_amdgcn_exp2f(-g * 1.4426950408889634f)) * u; }
struct EpiSwiglu {
    static constexpr bool PERM = true, AFTER_DRAIN = false;
    bf16_t* O; int ldc;
    __device__ __forceinline__ void operator()(const f32x4 (&acc)[2][2][4][2], const Unit& u, int wr, int wc, int fr, int fq) const {
        const int row0 = u.pm * BM + wr * 64 + fr, col0 = u.pn * HALF + wc * 32 + 8 * fq;
#pragma unroll
        for (int ai = 0; ai < 2; ++ai)
#pragma unroll
            for (int m = 0; m < 4; ++m) { bf16_t* rowp = O + (size_t)(row0 + ai * HALF + m * 16) * ldc + col0;
                const f32x4 g0 = acc[ai][0][m][0], g1 = acc[ai][0][m][1], u0 = acc[ai][1][m][0], u1 = acc[ai][1][m][1];
                u32x4 w;
                w.x = cvt_pk_bf16(silu_mul(g0[0], u0[0]), silu_mul(g0[1], u0[1])); w.y = cvt_pk_bf16(silu_mul(g0[2], u0[2]), silu_mul(g0[3], u0[3]));
                w.z = cvt_pk_bf16(silu_mul(g1[0], u1[0]), silu_mul(g1[1], u1[1])); w.w = cvt_pk_bf16(silu_mul(g1[2], u1[2]), silu_mul(g1[3], u1[3]));
                *(u32x4*)rowp = w; }
    }
};

struct EpiResid {
    static constexpr bool PERM = false, AFTER_DRAIN = false;
    const float* base; float* out; int ldc; const float* gate; int gstride; float mw;
    __device__ __forceinline__ void operator()(const f32x4 (&acc)[2][2][4][2], const Unit& u, int wr, int wc, int fr, int fq) const {
        const int row0 = u.pm * BM + wr * 64 + fr, col0 = u.pn * BM + wc * 32 + 4 * fq;
        const float* gp = gate + (size_t)(u.pm >> 3) * gstride + col0;
        f32x4 gv[2][2];
#pragma unroll
        for (int bj = 0; bj < 2; ++bj)
#pragma unroll
            for (int n = 0; n < 2; ++n) gv[bj][n] = (*(const f32x4*)(gp + bj * HALF + n * 16) + 1.0f) * mw;
#pragma unroll
        for (int ai = 0; ai < 2; ++ai)
#pragma unroll
            for (int m = 0; m < 4; ++m) { const size_t off = (size_t)(row0 + ai * HALF + m * 16) * ldc + col0;
#pragma unroll
                for (int bj = 0; bj < 2; ++bj)
#pragma unroll
                    for (int n = 0; n < 2; ++n) { const f32x4 bs = *(const f32x4*)(base + off + bj * HALF + n * 16); *(f32x4*)(out + off + bj * HALF + n * 16) = bs + gv[bj][n] * acc[ai][bj][m][n]; } }
    }
};

__device__ __forceinline__ float gelu_tanh(float x) { const float y = x * (1.5957691216057308f + 0.0713548162726f * x * x); return x * __builtin_amdgcn_rcpf(1.0f + __builtin_amdgcn_exp2f(-y * 1.4426950408889634f)); }
struct EpiLruIn {
    static constexpr bool PERM = false, AFTER_DRAIN = false;
    bf16_t* GG; float* XB; int ldc;
    __device__ __forceinline__ void operator()(const f32x4 (&acc)[2][2][4][2], const Unit& u, int wr, int wc, int fr, int fq) const {
        const int row0 = u.pm * BM + wr * 64 + fr;
        if (u.pn < 5) {
            const int col0 = u.pn * BM + wc * 32 + 4 * fq;
#pragma unroll
            for (int ai = 0; ai < 2; ++ai)
#pragma unroll
                for (int m = 0; m < 4; ++m) { bf16_t* rowp = GG + (size_t)(row0 + ai * HALF + m * 16) * ldc + col0;
#pragma unroll
                    for (int bj = 0; bj < 2; ++bj)
#pragma unroll
                        for (int n = 0; n < 2; ++n) { const f32x4 v = acc[ai][bj][m][n]; u32x2 w; w.x = cvt_pk_bf16(gelu_tanh(v[0]), gelu_tanh(v[1])); w.y = cvt_pk_bf16(gelu_tanh(v[2]), gelu_tanh(v[3]));
                            *(u32x2*)(rowp + bj * HALF + n * 16) = w; } }
        } else {
            const int col0 = (u.pn - 5) * BM + wc * 32 + 4 * fq;
#pragma unroll
            for (int ai = 0; ai < 2; ++ai)
#pragma unroll
                for (int m = 0; m < 4; ++m) { float* rowp = XB + (size_t)(row0 + ai * HALF + m * 16) * ldc + col0;
#pragma unroll
                    for (int bj = 0; bj < 2; ++bj)
#pragma unroll
                        for (int n = 0; n < 2; ++n) *(f32x4*)(rowp + bj * HALF + n * 16) = acc[ai][bj][m][n]; }
        }
    }
};

template <class Epi, class Sched, bool ALIGN_EPI = false, bool SP2 = false>
__device__ __forceinline__ void gemm_phase(PG8_LAS unsigned char* lds, const Gemm g, const Sched& S, const Epi& E) {
    const int tid = opaque_tid(), wid = __builtin_amdgcn_readfirstlane(tid >> 6), lane = tid & 63, wr = wid >> 2, wc = wid & 3, fr = lane & 15, fq = lane >> 4;
    const int K = g.K, nt = K / BK;
    unsigned voffA[2], voffB[2];
#pragma unroll
    for (int i = 0; i < 2; ++i) { int R, C; stage_rc(tid * 16 + i * 8192, R, C); const int Rb = Epi::PERM ? ((R & ~31) + perm32(R & 31)) : R;
        voffA[i] = (unsigned)(R * K + C) * 2u; voffB[i] = (unsigned)(Rb * K + C) * 2u; }
    const size_t kstep = (size_t)(BK * 2);
    const size_t hstep = (size_t)HALF * K * 2;
    const size_t tstep = 2 * hstep;
    const unsigned ldsw = (unsigned)wid * 1024u;
    const int aoff = lds_byte(wr * 64 + fr, fq * 8), boff = lds_byte(wc * 32 + fr, fq * 8);
#define PG8_SA(b, h) (((b) * 2 + (h)) * HTB)
#define PG8_SB(b, h) ((4 + (b) * 2 + (h)) * HTB)
#define PG8_STAGE(bufoff, gbase, voff) do { _Pragma("unroll") for (int _i = 0; _i < 2; ++_i) \
        __builtin_amdgcn_global_load_lds((const unsigned*)((const char*)(gbase) + (voff)[_i]), (PG8_LAS unsigned*)(lds + (bufoff) + ldsw + _i * 8192), 16, 0, 0); } while (0)
#define PG8_LDA(dst, b, h) do { _Pragma("unroll") for (int m = 0; m < 4; ++m) _Pragma("unroll") for (int k = 0; k < 2; ++k) dst[m][k] = *(const PG8_LAS bf16x8*)(lds + PG8_SA(b, h) + aoff + m * 2048 + k * 1024); } while (0)
#define PG8_LDB(dst, b, h) do { _Pragma("unroll") for (int n = 0; n < 2; ++n) _Pragma("unroll") for (int k = 0; k < 2; ++k) dst[n][k] = *(const PG8_LAS bf16x8*)(lds + PG8_SB(b, h) + boff + n * 2048 + k * 1024); } while (0)
#define PG8_MMA(ai, bj, At, Bt) do { __builtin_amdgcn_s_setprio(1); _Pragma("unroll") for (int m = 0; m < 4; ++m) _Pragma("unroll") for (int n = 0; n < 2; ++n) _Pragma("unroll") for (int k = 0; k < 2; ++k) \
        acc[ai][bj][m][n] = __builtin_amdgcn_mfma_f32_16x16x32_bf16(Bt[n][k], At[m][k], acc[ai][bj][m][n], 0, 0, 0); __builtin_amdgcn_s_setprio(0); } while (0)
#define PG8_WAIT_V(n) asm volatile("s_waitcnt vmcnt(" #n ")" ::: "memory")
#define PG8_WAIT_L(n) asm volatile("s_waitcnt lgkmcnt(" #n ")" ::: "memory")
#define PG8_BAR __builtin_amdgcn_s_barrier()
#define PG8_SCHED __builtin_amdgcn_sched_barrier(0)
    Unit cur, nxt; int ui = 0;
    if (!S.next(0, cur)) return;
    f32x4 acc[2][2][4][2];
#pragma unroll
    for (int a = 0; a < 2; ++a)
#pragma unroll
        for (int b = 0; b < 2; ++b)
#pragma unroll
            for (int m = 0; m < 4; ++m)
#pragma unroll
                for (int n = 0; n < 2; ++n) acc[a][b][m][n] = (f32x4){0.f, 0.f, 0.f, 0.f};
    bf16x8 At[4][2], B0[2][2], B1[2][2];
    const char* cA = (const char*)g.A + (size_t)cur.pm * tstep; const char* cB = (const char*)g.Bt + (size_t)cur.pn * tstep;
    S.a_ready(cur);
    if constexpr (SP2) {
        PG8_STAGE(PG8_SB(0, 0), cB, voffB); PG8_STAGE(PG8_SB(0, 1), cB + hstep, voffB); PG8_STAGE(PG8_SA(0, 0), cA, voffA); PG8_STAGE(PG8_SA(0, 1), cA + hstep, voffA);
        if (wr == 1) PG8_BAR;
        PG8_WAIT_V(2); PG8_BAR;
        PG8_STAGE(PG8_SB(1, 0), cB + kstep, voffB); PG8_STAGE(PG8_SA(1, 0), cA + kstep, voffA); PG8_STAGE(PG8_SB(1, 1), cB + hstep + kstep, voffB);
        PG8_WAIT_V(6); PG8_BAR;
    } else {
        PG8_STAGE(PG8_SB(0, 0), cB, voffB); PG8_STAGE(PG8_SA(0, 0), cA, voffA); PG8_STAGE(PG8_SB(0, 1), cB + hstep, voffB); PG8_STAGE(PG8_SA(0, 1), cA + hstep, voffA);
        if (wr == 1) PG8_BAR;
        PG8_WAIT_V(4); PG8_BAR;
        PG8_STAGE(PG8_SB(1, 0), cB + kstep, voffB); PG8_STAGE(PG8_SA(1, 0), cA + kstep, voffA); PG8_STAGE(PG8_SB(1, 1), cB + hstep + kstep, voffB);
        PG8_WAIT_V(6); PG8_BAR;
    }
    for (;;) {
        const bool has_next = S.next(ui + 1, nxt);
        const char* nA = has_next ? (const char*)g.A + (size_t)nxt.pm * tstep : cA; const char* nB = has_next ? (const char*)g.Bt + (size_t)nxt.pn * tstep : cB;
        for (int t = 0; t < nt; t += 2) {
            const bool last = (t == nt - 2);
            const char* a1 = cA + (size_t)(t + 1) * kstep;
            const char* a2 = last ? nA : cA + (size_t)(t + 2) * kstep; const char* b2 = last ? nB : cB + (size_t)(t + 2) * kstep;
            const char* a3 = a2 + kstep; const char* b3 = b2 + kstep;
            if (last && has_next) S.a_ready(nxt);
            if constexpr (SP2) {
            PG8_LDB(B0, 0, 0); PG8_LDB(B1, 0, 1); PG8_SCHED; PG8_LDA(At, 0, 0); PG8_STAGE(PG8_SA(1, 1), a1 + hstep, voffA);
            PG8_WAIT_V(8); PG8_WAIT_L(0); PG8_BAR; PG8_MMA(0, 0, At, B0); PG8_MMA(0, 1, At, B1); PG8_BAR; PG8_SCHED;
            PG8_LDA(At, 0, 1); PG8_STAGE(PG8_SB(0, 0), b2, voffB); PG8_STAGE(PG8_SB(0, 1), b2 + hstep, voffB); PG8_STAGE(PG8_SA(0, 0), a2, voffA);
            PG8_WAIT_V(8); PG8_WAIT_L(0); PG8_BAR; PG8_MMA(1, 0, At, B0); PG8_MMA(1, 1, At, B1); PG8_BAR; PG8_SCHED;
            PG8_LDB(B0, 1, 0); PG8_LDB(B1, 1, 1); PG8_SCHED; PG8_LDA(At, 1, 0); PG8_STAGE(PG8_SA(0, 1), a2 + hstep, voffA);
            PG8_WAIT_V(8); PG8_WAIT_L(0); PG8_BAR; PG8_MMA(0, 0, At, B0); PG8_MMA(0, 1, At, B1); PG8_BAR; PG8_SCHED;
            PG8_LDA(At, 1, 1); PG8_STAGE(PG8_SB(1, 0), b3, voffB); PG8_STAGE(PG8_SB(1, 1), b3 + hstep, voffB); PG8_STAGE(PG8_SA(1, 0), a3, voffA);
            PG8_WAIT_V(8); PG8_WAIT_L(0); PG8_BAR; PG8_MMA(1, 0, At, B0); PG8_MMA(1, 1, At, B1); PG8_BAR; PG8_SCHED;
            } else {
            PG8_LDB(B0, 0, 0); PG8_SCHED; PG8_LDA(At, 0, 0); PG8_STAGE(PG8_SA(1, 1), a1 + hstep, voffA);
            PG8_WAIT_L(8); PG8_BAR; PG8_WAIT_L(0); PG8_MMA(0, 0, At, B0); PG8_BAR; PG8_SCHED;
            PG8_LDB(B1, 0, 1); PG8_STAGE(PG8_SB(0, 0), b2, voffB);
            PG8_BAR; PG8_WAIT_L(0); PG8_MMA(0, 1, At, B1); PG8_BAR;
            PG8_LDA(At, 0, 1); PG8_STAGE(PG8_SA(0, 0), a2, voffA);
            PG8_BAR; PG8_WAIT_L(0); PG8_MMA(1, 0, At, B0); PG8_BAR; PG8_SCHED;
            PG8_STAGE(PG8_SB(0, 1), b2 + hstep, voffB);
            PG8_WAIT_V(6); PG8_BAR; PG8_MMA(1, 1, At, B1); PG8_BAR;
            PG8_LDB(B0, 1, 0); PG8_SCHED; PG8_LDA(At, 1, 0); PG8_STAGE(PG8_SA(0, 1), a2 + hstep, voffA);
            PG8_WAIT_L(8); PG8_BAR; PG8_WAIT_L(0); PG8_MMA(0, 0, At, B0); PG8_BAR; PG8_SCHED;
            PG8_LDB(B1, 1, 1); PG8_STAGE(PG8_SB(1, 0), b3, voffB);
            PG8_BAR; PG8_WAIT_L(0); PG8_MMA(0, 1, At, B1); PG8_BAR;
            PG8_LDA(At, 1, 1); PG8_STAGE(PG8_SA(1, 0), a3, voffA);
            PG8_BAR; PG8_WAIT_L(0); PG8_MMA(1, 0, At, B0); PG8_BAR; PG8_SCHED;
            PG8_STAGE(PG8_SB(1, 1), b3 + hstep, voffB);
            PG8_WAIT_V(6); PG8_BAR; PG8_MMA(1, 1, At, B1); PG8_BAR;
            }
        }
        if constexpr (ALIGN_EPI) { if (wr == 0) PG8_BAR; }
        if constexpr (!Epi::AFTER_DRAIN) { E(acc, cur, wr, wc, fr, fq); S.done(cur); }
        if (!has_next) break;
#pragma unroll
        for (int a = 0; a < 2; ++a)
#pragma unroll
            for (int b = 0; b < 2; ++b)
#pragma unroll
                for (int m = 0; m < 4; ++m)
#pragma unroll
                    for (int n = 0; n < 2; ++n) acc[a][b][m][n] = (f32x4){0.f, 0.f, 0.f, 0.f};
        cur = nxt; cA = nA; cB = nB; ++ui;
        if constexpr (ALIGN_EPI) { if (wr == 1) PG8_BAR; }
    }
    PG8_WAIT_V(0);
    if constexpr (!ALIGN_EPI) { if (wr == 0) PG8_BAR; }
    PG8_BAR;
    if constexpr (Epi::AFTER_DRAIN) { E.fused(acc, cur, wr, wc, fr, fq, lds, wid, lane); S.done(cur); }
#undef PG8_SA
#undef PG8_SB
#undef PG8_STAGE
#undef PG8_LDA
#undef PG8_LDB
#undef PG8_MMA
#undef PG8_WAIT_V
#undef PG8_WAIT_L
#undef PG8_BAR
#undef PG8_SCHED
}
}
namespace sba {
using bf16x8 = __attribute__((ext_vector_type(8))) short;
using s16x4 = __attribute__((ext_vector_type(4))) short;
using f32x16 = __attribute__((ext_vector_type(16))) float;
using u32x4 = __attribute__((ext_vector_type(4))) unsigned;
typedef unsigned short bf16;
constexpr int DM = 1024, KVBLK = 64, QBLK = 32, QB = 256, SLOTB = 8192;
constexpr int LDS_K = 0, LDS_V = 2 * SLOTB, LDS_OST = 4 * SLOTB, LDS_BYTES = LDS_OST + 8 * 4096;
__device__ __forceinline__ int crow(int r, int hi) { return (r & 3) + 8 * (r >> 2) + 4 * hi; }
__device__ __forceinline__ void glds16(const void* gsrc, unsigned lds_dst) { unsigned keep;
    asm volatile("s_mov_b32 %0, m0\n\ts_mov_b32 m0, %2\n\ts_nop 0\n\tglobal_load_lds_dwordx4 %1, off\n\ts_mov_b32 m0, %0" : "=&s"(keep) : "v"(gsrc), "s"(lds_dst) : "memory"); }
typedef float f32x2_t __attribute__((ext_vector_type(2))); typedef __bf16 bf16x2_t __attribute__((ext_vector_type(2)));
__device__ __forceinline__ unsigned cvtpk_s(float lo, float hi) { f32x2_t v = {lo, hi}; bf16x2_t b = __builtin_convertvector(v, bf16x2_t); return __builtin_bit_cast(unsigned, b); }
#define SBA_WAIT_BAR() asm volatile("s_waitcnt vmcnt(0) lgkmcnt(0)\n\ts_barrier" ::: "memory")
typedef __attribute__((address_space(3))) const char* lds_cptr;

__device__ __forceinline__ void qkt(f32x16& p0, f32x16& p1, lds_cptr Kslot, const bf16x8* qr, int r32, int hi) {
    lds_cptr kb = Kslot + hi * 1024 + r32 * 16;
    const f32x16 z = f32x16{};
#pragma unroll
    for (int d0 = 0; d0 < 4; ++d0) {
        const bf16x8 b0 = *(const __attribute__((address_space(3))) bf16x8*)(kb + d0 * 2048);
        const bf16x8 b1 = *(const __attribute__((address_space(3))) bf16x8*)(kb + d0 * 2048 + 512);
        if (d0 == 0) { p0 = __builtin_amdgcn_mfma_f32_32x32x16_bf16(b0, qr[0], z, 0, 0, 0); p1 = __builtin_amdgcn_mfma_f32_32x32x16_bf16(b1, qr[0], z, 0, 0, 0); }
        else { p0 = __builtin_amdgcn_mfma_f32_32x32x16_bf16(b0, qr[d0], p0, 0, 0, 0); p1 = __builtin_amdgcn_mfma_f32_32x32x16_bf16(b1, qr[d0], p1, 0, 0, 0); } }
}
__device__ __forceinline__ void pv(f32x16* o, int vb, bf16x8 pa0, bf16x8 pa1, bf16x8 pa2, bf16x8 pa3) {
#pragma unroll
    for (int d0 = 0; d0 < 2; ++d0) { s16x4 lo[4], hi[4];
#pragma unroll
        for (int ks = 0; ks < 4; ++ks) {
            asm volatile("ds_read_b64_tr_b16 %0,%1 offset:%c2" : "=&v"(lo[ks]) : "v"(vb), "i"(d0 * 4096 + ks * 1024) : "memory");
            asm volatile("ds_read_b64_tr_b16 %0,%1 offset:%c2" : "=&v"(hi[ks]) : "v"(vb), "i"(d0 * 4096 + ks * 1024 + 512) : "memory"); }
        asm volatile("s_waitcnt lgkmcnt(0)" ::: "memory"); __builtin_amdgcn_sched_barrier(0);
#define SBA_PK(k) (bf16x8){lo[k][0], lo[k][1], lo[k][2], lo[k][3], hi[k][0], hi[k][1], hi[k][2], hi[k][3]}
        o[d0] = __builtin_amdgcn_mfma_f32_32x32x16_bf16(pa0, SBA_PK(0), o[d0], 0, 0, 0);
        o[d0] = __builtin_amdgcn_mfma_f32_32x32x16_bf16(pa1, SBA_PK(1), o[d0], 0, 0, 0);
        o[d0] = __builtin_amdgcn_mfma_f32_32x32x16_bf16(pa2, SBA_PK(2), o[d0], 0, 0, 0);
        o[d0] = __builtin_amdgcn_mfma_f32_32x32x16_bf16(pa3, SBA_PK(3), o[d0], 0, 0, 0);
#undef SBA_PK
    }
}

__device__ __forceinline__ void sb_weights(f32x16& p0, f32x16& p1, float& carry, int hi, int qk, bool diag) {
    f32x16 k0v, k1v;
#pragma unroll
    for (int r = 0; r < 16; ++r) {
        const float e0 = __builtin_amdgcn_exp2f(__builtin_fminf(p0[r], 64.f)), e1 = __builtin_amdgcn_exp2f(__builtin_fminf(p1[r], 64.f));
        float kp0 = __builtin_amdgcn_rcpf(1.0f + e0), kp1 = __builtin_amdgcn_rcpf(1.0f + e1);
        float sg0 = e0 * kp0, sg1 = e1 * kp1;
        if (diag) { const int kk = crow(r, hi); if (kk >= qk) { kp0 = 1.f; sg0 = 0.f; } if (kk + 32 >= qk) { kp1 = 1.f; sg1 = 0.f; } }
        k0v[r] = kp0; k1v[r] = kp1; p0[r] = sg0; p1[r] = sg1;
    }
    float R = carry;
#define SBA_GROUP(P, KV, g) do { \
        const float q2 = KV[4 * (g) + 3], q1 = q2 * KV[4 * (g) + 2], q0 = q1 * KV[4 * (g) + 1], gp = q0 * KV[4 * (g)]; \
        const unsigned own = __float_as_uint(gp); auto rr = __builtin_amdgcn_permlane32_swap(own, own, false, false); \
        const float other = __uint_as_float(rr[0] ^ rr[1] ^ own), pairp = __uint_as_float(rr[0]) * __uint_as_float(rr[1]); \
        const float rin = hi ? R : R * other; \
        P[4 * (g) + 3] *= rin; P[4 * (g) + 2] *= rin * q2; P[4 * (g) + 1] *= rin * q1; P[4 * (g)] *= rin * q0; \
        R *= pairp; } while (0)
    SBA_GROUP(p1, k1v, 3); SBA_GROUP(p1, k1v, 2); SBA_GROUP(p1, k1v, 1); SBA_GROUP(p1, k1v, 0);
    SBA_GROUP(p0, k0v, 3); SBA_GROUP(p0, k0v, 2); SBA_GROUP(p0, k0v, 1); SBA_GROUP(p0, k0v, 0);
#undef SBA_GROUP
    carry = R;
}

__device__ __forceinline__ void attn_unit(int b, int h, int qb, const bf16* Q, const bf16* K, const bf16* V, bf16* O, __attribute__((address_space(3))) char* shm) {
    const int tid = opaque_tid(), lane = tid & 63, r32 = lane & 31, hi = lane >> 5; const int wid = __builtin_amdgcn_readfirstlane(tid >> 6);
    const long rowbase = (long)b * SEQ; const int q0 = qb * QB;
    const bf16* Qw = Q + (rowbase + q0 + wid * QBLK) * DM + h * HD;
    const bf16* Kh = K + rowbase * DM + h * HD, * Vh = V + rowbase * DM + h * HD;
    const unsigned lds0 = (unsigned)(uintptr_t)shm;
    const bf16* ksrc = Kh + (long)lane * DM + wid * 8;
    const bf16* vsrc = Vh + (long)(16 * (wid & 3) + (lane >> 2)) * DM + (wid >> 2) * 32 + (lane & 3) * 8;
    const unsigned kdst = lds0 + LDS_K + wid * 1024, vdst = lds0 + LDS_V + wid * 1024;
#define SBA_DMA_K(t, slot) glds16(ksrc + (long)(t) * KVBLK * DM, (unsigned)__builtin_amdgcn_readfirstlane(kdst + (slot)))
#define SBA_DMA_V(t, slot) glds16(vsrc + (long)(t) * KVBLK * DM, (unsigned)__builtin_amdgcn_readfirstlane(vdst + (slot)))
    const int vb0 = (int)(lds0 + LDS_V) + ((lane >> 4) & 1) * 32 + (lane & 3) * 8 + (4 * hi + ((lane & 15) >> 2)) * 64;
    const lds_cptr shm3 = (lds_cptr)shm;
    const int NT = (q0 + QB) / KVBLK;
    SBA_DMA_K(NT - 1, 0); SBA_DMA_V(NT - 1, 0);
    bf16x8 qr[4];
#pragma unroll
    for (int d0 = 0; d0 < 4; ++d0) qr[d0] = *reinterpret_cast<const bf16x8*>(&Qw[(long)r32 * DM + d0 * 16 + hi * 8]);
    f32x16 o[2]; o[0] = f32x16{}; o[1] = f32x16{};
    float carry = 1.0f;
    const int qw0 = q0 + wid * QBLK;
    int slot = 0;
    for (int t = NT - 1; t >= 0; --t) {
        SBA_WAIT_BAR();
        if (t > 0) { SBA_DMA_K(t - 1, slot ^ SLOTB); SBA_DMA_V(t - 1, slot ^ SLOTB); }
        if (64 * t <= qw0) {
            f32x16 p0, p1;
            qkt(p0, p1, shm3 + LDS_K + slot, qr, r32, hi);
            sb_weights(p0, p1, carry, hi, qw0 + r32 - 64 * t, 64 * t + 64 > qw0);
            u32x4 pw0, pw1, pw2, pw3;
            pw0 = (u32x4){cvtpk_s(p0[0], p0[1]), cvtpk_s(p0[2], p0[3]), cvtpk_s(p0[4], p0[5]), cvtpk_s(p0[6], p0[7])};
            pw1 = (u32x4){cvtpk_s(p0[8], p0[9]), cvtpk_s(p0[10], p0[11]), cvtpk_s(p0[12], p0[13]), cvtpk_s(p0[14], p0[15])};
            pw2 = (u32x4){cvtpk_s(p1[0], p1[1]), cvtpk_s(p1[2], p1[3]), cvtpk_s(p1[4], p1[5]), cvtpk_s(p1[6], p1[7])};
            pw3 = (u32x4){cvtpk_s(p1[8], p1[9]), cvtpk_s(p1[10], p1[11]), cvtpk_s(p1[12], p1[13]), cvtpk_s(p1[14], p1[15])};
            __builtin_amdgcn_sched_barrier(0);
            pv(o, vb0 + slot, __builtin_bit_cast(bf16x8, pw0), __builtin_bit_cast(bf16x8, pw1), __builtin_bit_cast(bf16x8, pw2), __builtin_bit_cast(bf16x8, pw3));
        }
        slot ^= SLOTB;
    }
    bf16* Ow = O + (rowbase + q0 + wid * QBLK) * DM + h * HD;
    { __attribute__((address_space(3))) bf16* stg = (__attribute__((address_space(3))) bf16*)(shm3 + LDS_OST) + wid * 2048;
#pragma unroll
      for (int r = 0; r < 16; ++r) { const int orow = crow(r, hi);
#pragma unroll
        for (int d0 = 0; d0 < 2; ++d0) { const unsigned pk = cvtpk_s(o[d0][r], 0.f); stg[orow * 64 + d0 * 32 + r32] = (bf16)(pk & 0xffffu); } }
      asm volatile("s_waitcnt lgkmcnt(0)" ::: "memory");
#pragma unroll
      for (int i = 0; i < 4; ++i) { const int row = i * 8 + (lane >> 3), ch = lane & 7; const u32x4 v = *(const __attribute__((address_space(3))) u32x4*)(stg + row * 64 + ch * 8); *(u32x4*)(Ow + (long)row * DM + ch * 8) = v; } }
    asm volatile("s_waitcnt lgkmcnt(0)\n\ts_barrier" ::: "memory");
#undef SBA_DMA_K
#undef SBA_DMA_V
}
#undef SBA_WAIT_BAR
}

#define GAS __attribute__((address_space(1)))
#define LAS __attribute__((address_space(3)))
typedef unsigned short bf16;
typedef unsigned v4u __attribute__((ext_vector_type(4)));
typedef unsigned v2u __attribute__((ext_vector_type(2)));
typedef float f32x4 __attribute__((ext_vector_type(4)));
typedef short bf16x8 __attribute__((ext_vector_type(8)));
typedef GAS unsigned gu32;
#define RLX_AGENT __ATOMIC_RELAXED, __HIP_MEMORY_SCOPE_AGENT
#define LDS_WAIT() asm volatile("s_waitcnt lgkmcnt(0)" ::: "memory")
#define VM_WAIT() asm volatile("s_waitcnt vmcnt(0)" ::: "memory")
constexpr int NWAVES = 8;

constexpr size_t MiB = 1u << 20;
constexpr size_t WS_CTL = 0, CTL_ZERO_BYTES = 1 * MiB;
constexpr size_t WS_MOD = 1 * MiB;
constexpr size_t WS_SA = 2 * MiB, WS_SB = 3 * MiB;
constexpr size_t WS_WGU = 4 * MiB;
constexpr size_t WS_WDN = 48 * MiB;
constexpr size_t WS_WQKV = 70 * MiB, WS_WO = 76 * MiB, WS_WIN = 78 * MiB, WS_WOUT = 83 * MiB, WS_WRI = 86 * MiB;
constexpr size_t WS_XN = 88 * MiB;
constexpr size_t WS_OV = 120 * MiB;
constexpr size_t WS_ACT = WS_OV, WS_QO = WS_OV, WS_K = WS_OV + 32 * MiB, WS_V = WS_OV + 64 * MiB, WS_GG = WS_OV, WS_XB = WS_OV + 40 * MiB;
constexpr size_t WS_END = 240 * MiB;
constexpr size_t WS_SCR = 256 * MiB, WS_SCR_END = 320 * MiB;
static_assert(WS_WGU + 4 * (size_t)NGU * D * 2 <= WS_WDN && WS_WDN + 4 * (size_t)D * FF * 2 <= WS_WQKV && WS_WQKV + (size_t)NQKV * D * 2 <= WS_WO && WS_WO + (size_t)D * D * 2 <= WS_WIN &&
              WS_WIN + (size_t)NIN * D * 2 <= WS_WOUT && WS_WOUT + (size_t)D * DR * 2 <= WS_WRI && WS_WRI + 10 * 256 * 128 * 2 <= WS_XN && WS_XN + (size_t)M * D * 2 <= WS_OV &&
              WS_ACT + (size_t)M * FF * 2 <= WS_END && WS_V + (size_t)M * D * 2 <= WS_END && WS_XB + (size_t)M * DR * 4 <= WS_END && WS_GG + (size_t)M * DR * 2 <= WS_XB, "d_ws map");
constexpr int CW_BAR = 4096;

constexpr int RING_OFF = 0, RING_BYTES = 131072;
constexpr int LDS_BYTES = 155648;
constexpr int MISC_OFF = LDS_BYTES - 256;

__device__ __forceinline__ unsigned f2bf(float f) { unsigned u = __builtin_bit_cast(unsigned, f); return (u + 0x7fffu + ((u >> 16) & 1u)) >> 16; }
__device__ __forceinline__ unsigned pk2(float lo, float hi) { return f2bf(lo) | (f2bf(hi) << 16); }
__device__ __forceinline__ float bf2f(unsigned short b) { return __builtin_bit_cast(float, (unsigned)b << 16); }

#define XB_TMO      128
#define XB_XCNT(j)  (256  + 64 * (j))
#define XB_XSUB(j)  (1280 + 64 * (j))
#define XB_XGEN(j)  (2304 + 64 * (j))
#define XB_TOP      3328
#define XB_TOPGEN   3392
#define XCD_BAR_WORDS 3456
#define XB_SPIN_CAP (1u << 18)
__device__ __forceinline__ unsigned xb_ld(unsigned* p)              { return __hip_atomic_load(p, __ATOMIC_RELAXED, __HIP_MEMORY_SCOPE_AGENT); }
__device__ __forceinline__ unsigned xb_add(unsigned* p, unsigned v) { return __hip_atomic_fetch_add(p, v, __ATOMIC_RELAXED, __HIP_MEMORY_SCOPE_AGENT); }
__device__ __forceinline__ unsigned xb_xcc_id() { return (unsigned)__builtin_amdgcn_s_getreg((3 << 11) | 20) & 0xFu; }
#define XB_SPIN(cond, bar) do { unsigned _sp = 0; while (cond) { __builtin_amdgcn_s_sleep(1); \
    if ((++_sp & 255u) == 0u) { if (xb_ld(&(bar)[XB_TMO])) break; if (_sp > XB_SPIN_CAP) { atomicAdd(&(bar)[XB_TMO], 1u); break; } } } } while (0)
struct XcdBarrier { unsigned* bar; unsigned x; volatile LAS unsigned* st; };
__device__ __forceinline__ XcdBarrier xcd_barrier_post(unsigned* bar, volatile LAS unsigned* st) {
    XcdBarrier b; b.bar = bar; b.x = xb_xcc_id(); b.st = st;
    if (threadIdx.x == 0) (void)xb_add(&bar[XB_XCNT(b.x)], 1u);
    return b;
}
__device__ __forceinline__ void xcd_barrier_complete(unsigned* bar, unsigned x, unsigned& nloc, unsigned& nx) {
    const unsigned G = gridDim.x * gridDim.y * gridDim.z;
    unsigned sum, cnt, mine, sp = 0u;
    for (;;) {
        sum = 0u; cnt = 0u; mine = 0u;
#pragma unroll
        for (unsigned j = 0; j < 16; ++j) { const unsigned c = xb_ld(&bar[XB_XCNT(j)]); sum += c; cnt += (c > 0u) ? 1u : 0u; mine = (j == x) ? c : mine; }
        if (sum == G) break;
        __builtin_amdgcn_s_sleep(1);
        if ((++sp & 255u) == 0u) { if (xb_ld(&bar[XB_TMO])) break; if (sp > XB_SPIN_CAP) { atomicAdd(&bar[XB_TMO], 1u); break; } }
    }
    nloc = mine > 0u ? mine : 1u; nx = cnt > 0u ? cnt : 1u;
}
__device__ __forceinline__ void xcd_barrier(const XcdBarrier& b) {
    asm volatile("s_waitcnt vmcnt(0)" ::: "memory");
    __syncthreads();
    if (threadIdx.x == 0) {
        GAS unsigned* barg = (GAS unsigned*)b.bar; asm volatile("" : "+s"(barg)); unsigned* bar = (unsigned*)barg;
        __builtin_amdgcn_s_waitcnt(0);
        unsigned nloc = b.st[0], nx = b.st[1];
        if (nloc == 0u) { xcd_barrier_complete(bar, b.x, nloc, nx); b.st[0] = nloc; b.st[1] = nx; }
        const unsigned old = xb_add(&bar[XB_XSUB(b.x)], 1u);
        const unsigned gen = old / nloc;
        if (old + 1u == (gen + 1u) * nloc) {
            __builtin_amdgcn_fence(__ATOMIC_RELEASE, "agent");
            asm volatile("s_waitcnt vmcnt(0)" ::: "memory");
            const unsigned og = xb_add(&bar[XB_TOP], 1u);
            const unsigned tg = og / nx;
            if (og + 1u == (tg + 1u) * nx) xb_add(&bar[XB_TOPGEN], 1u);
            else XB_SPIN(xb_ld(&bar[XB_TOPGEN]) == tg, bar);
            __builtin_amdgcn_fence(__ATOMIC_ACQUIRE, "agent");
            xb_add(&bar[XB_XGEN(b.x)], 1u);
            asm volatile("s_waitcnt vmcnt(0)" ::: "memory");
        } else {
            XB_SPIN(xb_ld(&bar[XB_XGEN(b.x)]) == gen, bar);
            __builtin_amdgcn_fence(__ATOMIC_ACQUIRE, "agent");
            asm volatile("s_waitcnt vmcnt(0)" ::: "memory");
        }
    }
    __syncthreads();
}

struct Args { const float* in[19]; float* out; unsigned char* ws; int ph_lo, ph_hi, use_bar, dup; };

__device__ __forceinline__ float wave_sum(float v) {
#pragma unroll
    for (int o = 1; o < 64; o <<= 1) v += __shfl_xor(v, o);
    return v;
}

__device__ __forceinline__ void tr_tile(const float* src, int lds_, bf16* dst, int ldd, LAS float* scr, int lane) {
#pragma unroll 8
    for (int i = 0; i < 32; ++i) { const int kk = 2 * i + (lane >> 5); scr[kk * 33 + (lane & 31)] = src[(size_t)kk * lds_ + (lane & 31)]; }
    LDS_WAIT(); asm volatile("" ::: "memory");
    const int c = lane & 7;
#pragma unroll
    for (int j = 0; j < 4; ++j) { const int n = (lane >> 3) + 8 * j; const LAS float* s = scr + (8 * c) * 33 + n;
        v4u o; o.x = pk2(s[0 * 33], s[1 * 33]); o.y = pk2(s[2 * 33], s[3 * 33]); o.z = pk2(s[4 * 33], s[5 * 33]); o.w = pk2(s[6 * 33], s[7 * 33]);
        *(GAS v4u*)(dst + (size_t)n * ldd + 8 * c) = o; }
    LDS_WAIT(); asm volatile("" ::: "memory");
}
__device__ __forceinline__ void tr_plain(const float* W, int K, int N, bf16* WT, LAS float* scr, int item, int lane) {
    const int nblk = N / 32, kb = item / nblk, nb = item % nblk, k0 = 64 * kb, n0 = 32 * nb;
    tr_tile(W + (size_t)k0 * N + n0, N, WT + (size_t)n0 * K + k0, K, scr, lane);
}
__device__ __forceinline__ void p0_prologue(const Args& a, unsigned char* ws, LAS unsigned char* lds, int vcu, int G, int tid, int lane, int wave) {
    LAS float* scr = (LAS float*)(lds + wave * 8448);
    const int gw = vcu * NWAVES + wave, NGW = G * NWAVES;
    constexpr int I_GU = (D / 64) * (NGU / 32), I_DN = (FF / 64) * (D / 32), I_QKV = (D / 64) * (NQKV / 32), I_O = (D / 64) * (D / 32), I_IN = (D / 64) * (NIN / 32), I_OUT = (DR / 64) * (D / 32), I_G = 2 * 4;
    constexpr int NITEMS = 4 * I_GU + 4 * I_DN + I_QKV + I_O + I_IN + I_OUT + 20 * I_G;
    for (int it = gw; it < NITEMS; it += NGW) {
        int r = it;
        if (r < 4 * I_GU) {
            const int mat = r / I_GU, item = r % I_GU; const int nblk = NGU / 32, kb = item / nblk, nb = item % nblk, k0 = 64 * kb, n0 = 32 * nb;
            const int isu = n0 >= FF ? 1 : 0, ff0 = n0 - isu * FF, L0 = (ff0 >> 7) * 256 + isu * 128 + (ff0 & 127);
            const float* W = a.in[5] + (size_t)mat * D * NGU; bf16* WT = (bf16*)(ws + WS_WGU) + (size_t)mat * NGU * D;
            tr_tile(W + (size_t)k0 * NGU + n0, NGU, WT + (size_t)L0 * D + k0, D, scr, lane); continue; }
        r -= 4 * I_GU;
        if (r < 4 * I_DN) { const int mat = r / I_DN; tr_plain(a.in[6] + (size_t)mat * FF * D, FF, D, (bf16*)(ws + WS_WDN) + (size_t)mat * D * FF, scr, r % I_DN, lane); continue; }
        r -= 4 * I_DN;
        if (r < I_QKV) { tr_plain(a.in[7], D, NQKV, (bf16*)(ws + WS_WQKV), scr, r, lane); continue; } r -= I_QKV;
        if (r < I_O) { tr_plain(a.in[8], D, D, (bf16*)(ws + WS_WO), scr, r, lane); continue; } r -= I_O;
        if (r < I_IN) { tr_plain(a.in[9], D, NIN, (bf16*)(ws + WS_WIN), scr, r, lane); continue; } r -= I_IN;
        if (r < I_OUT) { tr_plain(a.in[17], DR, D, (bf16*)(ws + WS_WOUT), scr, r, lane); continue; } r -= I_OUT;
        { const int mat = r / I_G, item = r % I_G, n = mat >> 1, isi = mat & 1;
          tr_plain((isi ? a.in[14] : a.in[12]) + (size_t)n * 128 * 128, 128, 128, (bf16*)(ws + WS_WRI) + (size_t)n * 256 * 128 + (size_t)isi * 128 * 128, scr, item, lane); }
    }
    __syncthreads();
    LAS float* ca = (LAS float*)lds;
    LAS float* part = (LAS float*)(lds + 32768);
    for (int i = tid; i < BATCH * D; i += NWAVES * 64) { const int b = i / D, k = i % D; const float c = a.in[1][i]; ca[k * 8 + b] = c * __builtin_amdgcn_rcpf(1.0f + __builtin_amdgcn_exp2f(-c * LOG2E)); }
    __syncthreads();
    float* MOD = (float*)(ws + WS_MOD);
    for (int ch = vcu; ch < 2 * NMOD / 72; ch += G) {
        const int g0 = ch * 72, l = g0 / NMOD, j0 = g0 % NMOD;
        const float* W = a.in[2] + (size_t)l * D * NMOD + j0;
        const int rs = lane / 18, cg = lane % 18;
        f32x4 acc[8];
#pragma unroll
        for (int b = 0; b < 8; ++b) acc[b] = (f32x4){0.f, 0.f, 0.f, 0.f};
        if (rs < 3) {
#pragma unroll 4
            for (int i = 0; i < 43; ++i) { const int kl = 3 * i + rs; if (kl < 128) { const int k = wave * 128 + kl;
                const f32x4 w = *(const f32x4*)(W + (size_t)k * NMOD + 4 * cg);
                const f32x4 c0 = *(const LAS f32x4*)(ca + k * 8), c1 = *(const LAS f32x4*)(ca + k * 8 + 4);
                acc[0] += w * c0[0]; acc[1] += w * c0[1]; acc[2] += w * c0[2]; acc[3] += w * c0[3]; acc[4] += w * c1[0]; acc[5] += w * c1[1]; acc[6] += w * c1[2]; acc[7] += w * c1[3]; } }
#pragma unroll
            for (int b = 0; b < 8; ++b) *(LAS f32x4*)(part + ((wave * 3 + rs) * 8 + b) * 72 + 4 * cg) = acc[b];
        }
        __syncthreads();
        for (int o = tid; o < 8 * 72; o += NWAVES * 64) { const int b = o / 72, j = o % 72; float s = a.in[3][(size_t)l * NMOD + j0 + j];
#pragma unroll
            for (int p = 0; p < 24; ++p) s += part[(p * 8 + b) * 72 + j];
            MOD[((size_t)l * BATCH + b) * NMOD + j0 + j] = s; }
        __syncthreads();
    }
}

__device__ __forceinline__ void norm_mod_phase(const float* x, const float* g, const float* shift, const float* scale, bf16* XN, int vcu, int G, int lane, int wave) {
    const int gw = vcu * NWAVES + wave, NGW = G * NWAVES;
    for (int blk = gw; blk < M / 8; blk += NGW) {
        const int row0 = blk * 8, b = row0 / SEQ;
        f32x4 gs[4], sh[4];
#pragma unroll
        for (int j = 0; j < 4; ++j) { const int c = 4 * lane + 256 * j; gs[j] = *(const f32x4*)(g + c) * (*(const f32x4*)(scale + (size_t)b * NMOD + c) + 1.0f); sh[j] = *(const f32x4*)(shift + (size_t)b * NMOD + c); }
#pragma unroll 2
        for (int r = 0; r < 8; ++r) {
            const f32x4* xr = (const f32x4*)(x + (size_t)(row0 + r) * D) + lane;
            f32x4 v[4]; float s = 0.f;
#pragma unroll
            for (int j = 0; j < 4; ++j) { v[j] = xr[64 * j]; s += (v[j].x * v[j].x + v[j].y * v[j].y) + (v[j].z * v[j].z + v[j].w * v[j].w); }
            const float inv = 1.0f / sqrtf(wave_sum(s) * (1.f / D) + RMS_EPS);
            v2u* o8 = (v2u*)(XN + (size_t)(row0 + r) * D) + lane;
#pragma unroll
            for (int j = 0; j < 4; ++j) { const f32x4 h = v[j] * inv * gs[j] + sh[j]; v2u w; w.x = pk2(h.x, h.y); w.y = pk2(h.z, h.w); o8[64 * j] = w; }
        }
    }
}
__device__ __forceinline__ void final_norm_phase(const float* x, const float* g, float* out, int vcu, int G, int lane, int wave) {
    const int gw = vcu * NWAVES + wave, NGW = G * NWAVES;
    f32x4 gs[4];
#pragma unroll
    for (int j = 0; j < 4; ++j) gs[j] = *(const f32x4*)(g + 4 * lane + 256 * j);
    for (int row = gw; row < M; row += NGW) {
        const f32x4* xr = (const f32x4*)(x + (size_t)row * D) + lane;
        f32x4 v[4]; float s = 0.f;
#pragma unroll
        for (int j = 0; j < 4; ++j) { v[j] = xr[64 * j]; s += (v[j].x * v[j].x + v[j].y * v[j].y) + (v[j].z * v[j].z + v[j].w * v[j].w); }
        const float inv = 1.0f / sqrtf(wave_sum(s) * (1.f / D) + RMS_EPS);
        f32x4* o = (f32x4*)(out + (size_t)row * D) + lane;
#pragma unroll
        for (int j = 0; j < 4; ++j) o[64 * j] = v[j] * inv * gs[j];
    }
}

namespace lru {
constexpr int WSTR = 272;
constexpr int OFF_W = 0;
constexpr int OFF_XT = OFF_W + 256 * WSTR;
constexpr int OFF_AT = OFF_XT + 35 * 512;
constexpr int OFF_XC = OFF_AT + 32 * WSTR;
constexpr int OFF_A = OFF_XC + 32 * 512;
constexpr int OFF_B = OFF_A + 32 * 512;
constexpr int OFF_P = OFF_B + 32 * 512;
constexpr int LDS_END = OFF_P + 8 * 512;
static_assert(LDS_END <= MISC_OFF, "lru LDS map");
__device__ __forceinline__ float sigmoidf_(float x) { return __builtin_amdgcn_rcpf(1.0f + __builtin_amdgcn_exp2f(-x * LOG2E)); }

template <int PASS> __device__ __forceinline__ void lru_unit(const Args& a, unsigned char* ws, bf16* Yout, LAS unsigned char* lds, int chunk, int n, int tid, int lane, int wave) {
    const bf16* Wg = (const bf16*)(ws + WS_WRI) + (size_t)n * 256 * 128;
    float* XB = (float*)(ws + WS_XB); bf16* GG = (bf16*)(ws + WS_GG); float* SA = (float*)(ws + WS_SA); float* SB = (float*)(ws + WS_SB);
    LAS float* XT = (LAS float*)(lds + OFF_XT); LAS float* XC = (LAS float*)(lds + OFF_XC); LAS float* Aa = (LAS float*)(lds + OFF_A); LAS float* Bb = (LAS float*)(lds + OFF_B); LAS float* P = (LAS float*)(lds + OFF_P);
    for (int i = tid; i < 256 * 16; i += NWAVES * 64) { const int row = i >> 4, c16 = i & 15; *(LAS v4u*)(lds + OFF_W + row * WSTR + c16 * 16) = *(const v4u*)(Wg + row * 128 + c16 * 8); }
    if (tid < 128) { const int ch = n * 128 + tid;
        P[0 * 128 + tid] = a.in[10][0 * DR + ch]; P[1 * 128 + tid] = a.in[10][1 * DR + ch]; P[2 * 128 + tid] = a.in[10][2 * DR + ch]; P[3 * 128 + tid] = a.in[10][3 * DR + ch];
        P[4 * 128 + tid] = a.in[11][ch]; P[5 * 128 + tid] = a.in[13][ch]; P[6 * 128 + tid] = a.in[15][ch]; P[7 * 128 + tid] = 8.0f * log1pf(expf(-a.in[16][ch])); }
    float h = 0.f, Ac = 1.f;
    if (PASS == 2 && tid < 128) { const int cs = chunk & 15, c0 = chunk - cs;
        for (int c = 0; c < cs; ++c) { const size_t idx = (size_t)(c0 + c) * DR + n * 128 + tid; h = SA[idx] * h + SB[idx]; } }
    const int seq0 = (chunk >> 4) * SEQ;
    for (int sub = 0; sub < 4; ++sub) {
        const int r0 = chunk * 128 + sub * 32;
        for (int i = tid; i < 35 * 32; i += NWAVES * 64) { const int j = i >> 5, c4 = i & 31, grow = r0 - 3 + j;
            f32x4 v = (f32x4){0.f, 0.f, 0.f, 0.f}; if (grow >= seq0) v = *(const f32x4*)(XB + (size_t)grow * DR + n * 128 + 4 * c4);
            *(LAS f32x4*)(XT + j * 128 + 4 * c4) = v; }
        __syncthreads();
        { const int row = tid >> 4, c8 = (tid & 15) * 8; float xc[8];
#pragma unroll
          for (int e = 0; e < 8; ++e) { const int ch = c8 + e; float s = P[4 * 128 + ch];
#pragma unroll
              for (int tap = 0; tap < 4; ++tap) s += XT[(row + tap) * 128 + ch] * P[tap * 128 + ch];
              xc[e] = s; XC[row * 128 + ch] = s; }
          v4u o; o.x = pk2(xc[0], xc[1]); o.y = pk2(xc[2], xc[3]); o.z = pk2(xc[4], xc[5]); o.w = pk2(xc[6], xc[7]);
          *(LAS v4u*)(lds + OFF_AT + row * WSTR + c8 * 2) = o; }
        __syncthreads();
        { const int rg = wave & 1, cq = wave >> 1, fr = lane & 15, fq = lane >> 4;
          f32x4 acc[4];
#pragma unroll
          for (int t = 0; t < 4; ++t) acc[t] = (f32x4){0.f, 0.f, 0.f, 0.f};
#pragma unroll
          for (int ks = 0; ks < 4; ++ks) { const bf16x8 af = *(const LAS bf16x8*)(lds + OFF_AT + (16 * rg + fr) * WSTR + (32 * ks + 8 * fq) * 2);
#pragma unroll
              for (int t = 0; t < 4; ++t) { const int orow = (t >> 1) * 128 + 32 * cq + 16 * (t & 1) + fr; const bf16x8 bfg = *(const LAS bf16x8*)(lds + OFF_W + orow * WSTR + (32 * ks + 8 * fq) * 2);
                  acc[t] = __builtin_amdgcn_mfma_f32_16x16x32_bf16(bfg, af, acc[t], 0, 0, 0); } }
          const int row = 16 * rg + fr;
#pragma unroll
          for (int tt = 0; tt < 2; ++tt)
#pragma unroll
              for (int e = 0; e < 4; ++e) { const int ch = 32 * cq + 16 * tt + 4 * fq + e;
                  const float r = sigmoidf_(acc[tt][e] + P[5 * 128 + ch]), ig = sigmoidf_(acc[2 + tt][e] + P[6 * 128 + ch]);
                  const float la = -r * P[7 * 128 + ch], av = expf(la), bv = sqrtf(-expm1f(2.0f * la)) * (ig * XC[row * 128 + ch]);
                  Aa[row * 128 + ch] = av; Bb[row * 128 + ch] = bv; } }
        __syncthreads();
        if (tid < 128) {
#pragma unroll 8
            for (int r = 0; r < 32; ++r) { const float av = Aa[r * 128 + tid], bv = Bb[r * 128 + tid]; h = av * h + bv; Ac *= av; if (PASS == 2) Bb[r * 128 + tid] = h; } }
        if (PASS == 2) {
            __syncthreads();
            const int row = tid >> 4, c8 = (tid & 15) * 8; bf16* gp = GG + (size_t)(r0 + row) * DR + n * 128 + c8;
            const v4u gv = *(const v4u*)gp; const LAS float* hp = Bb + row * 128 + c8;
            v4u o;
            o.x = pk2(bf2f((unsigned short)(gv.x & 0xffffu)) * hp[0], bf2f((unsigned short)(gv.x >> 16)) * hp[1]); o.y = pk2(bf2f((unsigned short)(gv.y & 0xffffu)) * hp[2], bf2f((unsigned short)(gv.y >> 16)) * hp[3]);
            o.z = pk2(bf2f((unsigned short)(gv.z & 0xffffu)) * hp[4], bf2f((unsigned short)(gv.z >> 16)) * hp[5]); o.w = pk2(bf2f((unsigned short)(gv.w & 0xffffu)) * hp[6], bf2f((unsigned short)(gv.w >> 16)) * hp[7]);
            *(v4u*)(Yout + (size_t)(r0 + row) * DR + n * 128 + c8) = o;
        }
    }
    if (PASS == 1 && tid < 128) { const size_t idx = (size_t)chunk * DR + n * 128 + tid; SA[idx] = Ac; SB[idx] = h; }
    __syncthreads();
}
}

enum { PH_PROLOGUE = 0, PH_NORM, PH_GU, PH_DOWN, PH_QKV, PH_ATTN, PH_WO, PH_WIN, PH_LRU1, PH_LRU2, PH_WOUT, PH_FINAL };
constexpr int NPHASES = 23;
__constant__ unsigned char PH_KIND[NPHASES] = { PH_PROLOGUE,
    PH_NORM, PH_GU, PH_DOWN,  PH_NORM, PH_QKV, PH_ATTN, PH_WO,            PH_NORM, PH_GU, PH_DOWN,
    PH_NORM, PH_GU, PH_DOWN,  PH_NORM, PH_WIN, PH_LRU1, PH_LRU2, PH_WOUT, PH_NORM, PH_GU, PH_DOWN,
    PH_FINAL };
__constant__ unsigned char PH_LAYER[NPHASES] = { 0, 0,0,0, 0,0,0,0, 0,0,0, 1,1,1, 1,1,1,1,1, 1,1,1, 1 };
__constant__ unsigned char PH_SUB[NPHASES]   = { 0, 0,0,0, 1,1,1,1, 2,2,2, 0,0,0, 1,1,1,1,1, 2,2,2, 0 };

__global__ void __launch_bounds__(NWAVES * 64, 2) fwd_kernel(Args args) {
    extern __shared__ __attribute__((aligned(16))) unsigned char lds_raw[];
    LAS unsigned char* lds = (LAS unsigned char*)lds_raw;
    volatile LAS unsigned* MISC = (volatile LAS unsigned*)(lds + MISC_OFF);
    const int tid0 = threadIdx.x;
    const int G = gridDim.x; const int bx = blockIdx.x; const int vcu = (G % 8 == 0) ? (bx % 8) * (G / 8) + bx / 8 : bx;
    unsigned char* ws0 = args.ws;
    gu32* ctl = (gu32*)(ws0 + WS_CTL);
    for (int u = tid0; u < 64; u += NWAVES * 64) MISC[u] = 0u;
    __syncthreads();
    XcdBarrier bar; bar.bar = (unsigned*)(ctl + CW_BAR); bar.x = 0; bar.st = nullptr;
    if (args.use_bar) bar = xcd_barrier_post((unsigned*)(ctl + CW_BAR), MISC + 8);

    float* X = args.out;

    for (int ph = args.ph_lo; ph < args.ph_hi; ++ph) {
        const int kind = PH_KIND[ph], l = PH_LAYER[ph], sub = PH_SUB[ph];
        const int reps = ((args.dup >> kind) & 1) ? 2 : 1;
        for (int rep = 0; rep < reps; ++rep) {
        int tid = tid0; asm volatile("" : "+v"(tid)); GAS unsigned char* wsg = (GAS unsigned char*)ws0; asm volatile("" : "+s"(wsg)); unsigned char* ws = (unsigned char*)wsg;
        const int lane = tid & 63, wave = __builtin_amdgcn_readfirstlane(tid >> 6);
        float* MOD = (float*)(ws + WS_MOD); bf16* XN = (bf16*)(ws + WS_XN);
        const float* modl = MOD + (size_t)l * BATCH * NMOD + (size_t)sub * 3 * D;
        const int fidx = l * 2 + (sub == 2 ? 1 : 0);
        const bool dry = rep + 1 < reps;
        if (kind == PH_PROLOGUE) {
            p0_prologue(args, ws, lds, vcu, G, tid, lane, wave);
        } else if (kind == PH_NORM) {
            const float* xin = (ph == 1) ? args.in[0] : X;
            norm_mod_phase(xin, args.in[4] + (size_t)(l * 3 + sub) * D, modl, modl + D, XN, vcu, G, lane, wave);
        } else if (kind == PH_GU) {
            pg8::Gemm g{XN, (const bf16*)(ws + WS_WGU) + (size_t)fidx * NGU * D, M, NGU, D}; pg8::StaticOrder S; S.init(M, NGU, G, bx);
            pg8::EpiSwiglu E{(bf16*)(ws + WS_ACT), FF};
            pg8::gemm_phase<pg8::EpiSwiglu, pg8::StaticOrder, true, true>(lds + RING_OFF, g, S, E);
        } else if (kind == PH_DOWN || kind == PH_WO || kind == PH_WOUT) {
            const bf16* A; const bf16* Bt; int K; float mw;
            if (kind == PH_DOWN) { A = (const bf16*)(ws + WS_ACT); Bt = (const bf16*)(ws + WS_WDN) + (size_t)fidx * D * FF; K = FF; mw = 0.5f; }
            else if (kind == PH_WO) { A = (const bf16*)(ws + WS_QO); Bt = (const bf16*)(ws + WS_WO); K = D; mw = 1.0f; }
            else { A = (const bf16*)(ws + WS_GG); Bt = (const bf16*)(ws + WS_WOUT); K = DR; mw = 1.0f; }
            const float* base = (ph == 3) ? args.in[0] : X;
            pg8::Gemm g{A, Bt, M, D, K}; pg8::StaticOrder S; S.init(M, D, G, bx);
            pg8::EpiResid E{base, dry ? (float*)(ws + WS_SCR) : X, D, modl + 2 * D, NMOD, mw};
            pg8::gemm_phase<pg8::EpiResid, pg8::StaticOrder, true, true>(lds + RING_OFF, g, S, E);
        } else if (kind == PH_QKV) {
            pg8::Gemm g{XN, (const bf16*)(ws + WS_WQKV), M, NQKV, D}; pg8::StaticOrder S; S.init(M, NQKV, G, bx);
            pg8::EpiQKV E{(bf16*)(ws + WS_QO), D, D, (size_t)(WS_K - WS_QO) / 2, 0.125f * LOG2E};
            pg8::gemm_phase<pg8::EpiQKV, pg8::StaticOrder, true, true>(lds + RING_OFF, g, S, E);
        } else if (kind == PH_ATTN) {
            const sba::bf16* Qp = (const sba::bf16*)(ws + WS_QO); const sba::bf16* Kp = (const sba::bf16*)(ws + WS_K); const sba::bf16* Vp = (const sba::bf16*)(ws + WS_V);
            sba::bf16* Op = (sba::bf16*)(ws + (dry ? WS_SCR : WS_QO));
            if (G == 256) {
                const int bh = vcu >> 1, hf = vcu & 1;
                for (int i = 0; i < 4; ++i) { const int qb = (i == 0) ? 7 - hf : (i == 1) ? hf : (i == 2) ? 5 - hf : 2 + hf;
                    sba::attn_unit(bh / NH, bh % NH, qb, Qp, Kp, Vp, Op, (LAS char*)(lds + RING_OFF)); }
            } else {
                for (int it = vcu; it < BATCH * NH * 8; it += G) sba::attn_unit((it >> 3) / NH, (it >> 3) % NH, it & 7, Qp, Kp, Vp, Op, (LAS char*)(lds + RING_OFF));
            }
        } else if (kind == PH_WIN) {
            pg8::Gemm g{XN, (const bf16*)(ws + WS_WIN), M, NIN, D}; pg8::StaticOrder S; S.init(M, NIN, G, bx);
            pg8::EpiLruIn E{(bf16*)(ws + WS_GG), (float*)(ws + WS_XB), DR};
            pg8::gemm_phase<pg8::EpiLruIn, pg8::StaticOrder, true, true>(lds + RING_OFF, g, S, E);
        } else if (kind == PH_LRU1) {
            for (int u = vcu; u < 1280; u += G) lru::lru_unit<1>(args, ws, nullptr, lds, u & 127, u >> 7, tid, lane, wave);
        } else if (kind == PH_LRU2) {
            for (int u = vcu; u < 1280; u += G) lru::lru_unit<2>(args, ws, (bf16*)(ws + (dry ? WS_SCR : WS_GG)), lds, u & 127, u >> 7, tid, lane, wave);
        } else {
            final_norm_phase(X, args.in[18], dry ? (float*)(ws + WS_SCR) : X, vcu, G, lane, wave);
        }
        if (dry) xcd_barrier(bar);
        }
        if (ph + 1 < args.ph_hi) xcd_barrier(bar);
    }
}

extern "C" void kernel_launch(void* const* d_in, const int* in_sizes, int n_in, void* d_out, int out_size, void* d_ws, size_t ws_size, hipStream_t stream) {
    static int grid = 0;
    if (grid == 0) {
        if (n_in != 19 || in_sizes[0] != M * D || out_size != M * D || ws_size < WS_SCR_END) { fprintf(stderr, "kernel_launch: unexpected shapes (n_in %d, in0 %d, out %d, ws %zu); nothing launched\n", n_in, n_in > 0 ? in_sizes[0] : -1, out_size, ws_size); grid = -1; return; }
        int dev = 0, cus = 0, per_cu = 0;
        if (hipGetDevice(&dev) != hipSuccess || hipDeviceGetAttribute(&cus, hipDeviceAttributeMultiprocessorCount, dev) != hipSuccess) { fprintf(stderr, "kernel_launch: device query failed\n"); grid = -1; return; }
        if (hipFuncSetAttribute((const void*)fwd_kernel, hipFuncAttributeMaxDynamicSharedMemorySize, LDS_BYTES) != hipSuccess) { fprintf(stderr, "kernel_launch: hipFuncSetAttribute failed\n"); grid = -1; return; }
        if (hipOccupancyMaxActiveBlocksPerMultiprocessor(&per_cu, (const void*)fwd_kernel, NWAVES * 64, LDS_BYTES) != hipSuccess || per_cu < 1)
            fprintf(stderr, "kernel_launch: note: occupancy query reports %d workgroups per CU\n", per_cu);
        (void)hipGetLastError();
        grid = cus;
    }
    if (grid < 0) return;
    if (hipMemsetAsync((char*)d_ws + WS_CTL, 0, CTL_ZERO_BYTES, stream) != hipSuccess) { fprintf(stderr, "kernel_launch: hipMemsetAsync failed\n"); return; }
    Args a{};
    for (int i = 0; i < 19; ++i) a.in[i] = (const float*)d_in[i];
    a.out = (float*)d_out; a.ws = (unsigned char*)d_ws; a.dup = PROBE_DUP;
#if MK_ONE_LAUNCH
    a.ph_lo = 0; a.ph_hi = NPHASES; a.use_bar = 1;
    hipLaunchKernelGGL(fwd_kernel, dim3(grid), dim3(NWAVES * 64), LDS_BYTES, stream, a);
#else
    for (int ph = 0; ph < NPHASES; ++ph) { a.ph_lo = ph; a.ph_hi = ph + 1; a.use_bar = 0;
        hipLaunchKernelGGL(fwd_kernel, dim3(grid), dim3(NWAVES * 64), LDS_BYTES, stream, a); }
#endif
    const hipError_t le = hipPeekAtLastError();
    if (le != hipSuccess) fprintf(stderr, "kernel_launch: launch failed: %s\n", hipGetErrorName(le));
}
```

```cpp
#include <hip/hip_runtime.h>
#include <hip/hip_bf16.h>
#include <cstdio>
#include <cstdint>
#include <cmath>

#ifndef PROBE_DUP
#define PROBE_DUP 0
#endif
#ifndef MK_ONE_LAUNCH
#define MK_ONE_LAUNCH 1
#endif

constexpr int BATCH = 8, SEQ = 2048, D = 1024, M = BATCH * SEQ, FF = 2816, NGU = 2 * FF, NQKV = 3 * D, DR = 1280, NIN = 2 * DR, NMOD = 9 * D, NH = 16, HD = 64;
constexpr float RMS_EPS = 1e-6f;
constexpr float LOG2E = 1.4426950408889634f;

__device__ __forceinline__ int opaque_tid() { int t = threadIdx.x; asm volatile("" : "+v"(t)); return t; }


namespace pg8 {
#define PG8_LAS __attribute__((address_space(3)))
typedef unsigned short bf16_t;
typedef short bf16x8 __attribute__((ext_vector_type(8)));
typedef float f32x4 __attribute__((ext_vector_type(4)));
typedef unsigned u32x4 __attribute__((ext_vector_type(4)));
constexpr int BM = 256, BK = 64, HALF = 128, HTB = HALF * BK * 2  , STAGE_BYTES = 8 * HTB, NXCD = 8, WGM = 8;

__host__ __device__ __forceinline__ int lds_byte(int r, int c) { const int st = (r >> 4) * 2 + (c >> 5), rr = r & 15, cc = c & 31, ob = rr * 64 + cc * 2; return st * 1024 + (ob ^ (((ob >> 9) & 1) << 5)); }
__host__ __device__ __forceinline__ void stage_rc(int b, int& R, int& C) { const int st = b / 1024, sb = b % 1024, swz = sb ^ (((sb >> 9) & 1) << 5); R = (st >> 1) * 16 + swz / 64; C = (st & 1) * 32 + (swz % 64) / 2; }
__host__ __device__ __forceinline__ int perm32(int rho) { const int n = rho >> 4, i = rho & 15; return 8 * (i >> 2) + 4 * n + (i & 3); }

struct Unit { int pm, pn; };
struct Gemm { const bf16_t* A; const bf16_t* Bt; int M, N, K; };

struct StaticOrder {
    int nM, nN, nwg, G, c;
    __host__ __device__ void init(int M, int N, int G_, int c_) { nM = M / BM; nN = N / BM; nwg = nM * nN; G = G_; c = c_; }
    __host__ __device__ bool next(int i, Unit& u) const {
        const long L = (long)i * G + c; if (L >= nwg) return false;
        int wgid = (int)L; { const int q = nwg / NXCD, r = nwg % NXCD, xcd = wgid % NXCD, off = wgid / NXCD; wgid = (xcd < r ? xcd * (q + 1) : r * (q + 1) + (xcd - r) * q) + off; }
        const int nig = WGM * nN, gid = wgid / nig, fm = gid * WGM, gsz = (nM - fm) < WGM ? (nM - fm) : WGM;
        u.pm = fm + ((wgid % nig) % gsz); u.pn = (wgid % nig) / gsz; return true;
    }
    __device__ __forceinline__ void a_ready(const Unit&) const {}
    __device__ __forceinline__ void done(const Unit&) const {}
};

__device__ __forceinline__ unsigned cvt_pk_bf16(float lo, float hi) { unsigned r; asm volatile("v_cvt_pk_bf16_f32 %0, %1, %2" : "=v"(r) : "v"(lo), "v"(hi)); return r; }
typedef unsigned u32x2 __attribute__((ext_vector_type(2)));

struct EpiQKV {
    static constexpr bool PERM = true, AFTER_DRAIN = false;
    bf16_t* O; int ldc; int split_cols; size_t split_stride; float scale0;
    __device__ __forceinline__ void operator()(const f32x4 (&acc)[2][2][4][2], const Unit& u, int wr, int wc, int fr, int fq) const {
        const int row0 = u.pm * BM + wr * 64 + fr; int colt = u.pn * BM; bf16_t* base = O;
        float sc = 1.f; { const int t = colt / split_cols; base += (size_t)t * split_stride; colt -= t * split_cols; if (t == 0) sc = scale0; }
        const int col0 = colt + wc * 32 + 8 * fq;
#pragma unroll
        for (int ai = 0; ai < 2; ++ai)
#pragma unroll
            for (int m = 0; m < 4; ++m) { bf16_t* rowp = base + (size_t)(row0 + ai * HALF + m * 16) * ldc + col0;
#pragma unroll
                for (int bj = 0; bj < 2; ++bj) { f32x4 v0 = acc[ai][bj][m][0] * sc, v1 = acc[ai][bj][m][1] * sc;
                    u32x4 w; w.x = cvt_pk_bf16(v0[0], v0[1]); w.y = cvt_pk_bf16(v0[2], v0[3]); w.z = cvt_pk_bf16(v1[0], v1[1]); w.w = cvt_pk_bf16(v1[2], v1[3]);
                    *(u32x4*)(rowp + bj * HALF) = w; } }
    }
};

__device__ __forceinline__ float silu_mul(float g, float u) { return g * __builtin_amdgcn_rcpf(1.0f + __builtin_amdgcn_exp2f(-g * 1.4426950408889634f)) * u; }
struct EpiSwiglu {
    static constexpr bool PERM = true, AFTER_DRAIN = false;
    bf16_t* O; int ldc;
    __device__ __forceinline__ void operator()(const f32x4 (&acc)[2][2][4][2], const Unit& u, int wr, int wc, int fr, int fq) const {
        const int row0 = u.pm * BM + wr * 64 + fr, col0 = u.pn * HALF + wc * 32 + 8 * fq;
#pragma unroll
        for (int ai = 0; ai < 2; ++ai)
#pragma unroll
            for (int m = 0; m < 4; ++m) { bf16_t* rowp = O + (size_t)(row0 + ai * HALF + m * 16) * ldc + col0;
                const f32x4 g0 = acc[ai][0][m][0], g1 = acc[ai][0][m][1], u0 = acc[ai][1][m][0], u1 = acc[ai][1][m][1];
                u32x4 w;
                w.x = cvt_pk_bf16(silu_mul(g0[0], u0[0]), silu_mul(g0[1], u0[1])); w.y = cvt_pk_bf16(silu_mul(g0[2], u0[2]), silu_mul(g0[3], u0[3]));
                w.z = cvt_pk_bf16(silu_mul(g1[0], u1[0]), silu_mul(g1[1], u1[1])); w.w = cvt_pk_bf16(silu_mul(g1[2], u1[2]), silu_mul(g1[3], u1[3]));
                *(u32x4*)rowp = w; }
    }
};

struct EpiResid {
    static constexpr bool PERM = false, AFTER_DRAIN = false;
    const float* base; float* out; int ldc; const float* gate; int gstride; float mw;
    __device__ __forceinline__ void operator()(const f32x4 (&acc)[2][2][4][2], const Unit& u, int wr, int wc, int fr, int fq) const {
        const int row0 = u.pm * BM + wr * 64 + fr, col0 = u.pn * BM + wc * 32 + 4 * fq;
        const float* gp = gate + (size_t)(u.pm >> 3) * gstride + col0;
        f32x4 gv[2][2];
#pragma unroll
        for (int bj = 0; bj < 2; ++bj)
#pragma unroll
            for (int n = 0; n < 2; ++n) gv[bj][n] = (*(const f32x4*)(gp + bj * HALF + n * 16) + 1.0f) * mw;
#pragma unroll
        for (int ai = 0; ai < 2; ++ai)
#pragma unroll
            for (int m = 0; m < 4; ++m) { const size_t off = (size_t)(row0 + ai * HALF + m * 16) * ldc + col0;
#pragma unroll
                for (int bj = 0; bj < 2; ++bj)
#pragma unroll
                    for (int n = 0; n < 2; ++n) { const f32x4 bs = *(const f32x4*)(base + off + bj * HALF + n * 16); *(f32x4*)(out + off + bj * HALF + n * 16) = bs + gv[bj][n] * acc[ai][bj][m][n]; } }
    }
};

__device__ __forceinline__ float gelu_tanh(float x) { const float y = x * (1.5957691216057308f + 0.0713548162726f * x * x); return x * __builtin_amdgcn_rcpf(1.0f + __builtin_amdgcn_exp2f(-y * 1.4426950408889634f)); }
struct EpiLruIn {
    static constexpr bool PERM = false, AFTER_DRAIN = false;
    bf16_t* GG; float* XB; int ldc;
    __device__ __forceinline__ void operator()(const f32x4 (&acc)[2][2][4][2], const Unit& u, int wr, int wc, int fr, int fq) const {
        const int row0 = u.pm * BM + wr * 64 + fr;
        if (u.pn < 5) {
            const int col0 = u.pn * BM + wc * 32 + 4 * fq;
#pragma unroll
            for (int ai = 0; ai < 2; ++ai)
#pragma unroll
                for (int m = 0; m < 4; ++m) { bf16_t* rowp = GG + (size_t)(row0 + ai * HALF + m * 16) * ldc + col0;
#pragma unroll
                    for (int bj = 0; bj < 2; ++bj)
#pragma unroll
                        for (int n = 0; n < 2; ++n) { const f32x4 v = acc[ai][bj][m][n]; u32x2 w; w.x = cvt_pk_bf16(gelu_tanh(v[0]), gelu_tanh(v[1])); w.y = cvt_pk_bf16(gelu_tanh(v[2]), gelu_tanh(v[3]));
                            *(u32x2*)(rowp + bj * HALF + n * 16) = w; } }
        } else {
            const int col0 = (u.pn - 5) * BM + wc * 32 + 4 * fq;
#pragma unroll
            for (int ai = 0; ai < 2; ++ai)
#pragma unroll
                for (int m = 0; m < 4; ++m) { float* rowp = XB + (size_t)(row0 + ai * HALF + m * 16) * ldc + col0;
#pragma unroll
                    for (int bj = 0; bj < 2; ++bj)
#pragma unroll
                        for (int n = 0; n < 2; ++n) *(f32x4*)(rowp + bj * HALF + n * 16) = acc[ai][bj][m][n]; }
        }
    }
};

template <class Epi, class Sched, bool ALIGN_EPI = false, bool SP2 = false>
__device__ __forceinline__ void gemm_phase(PG8_LAS unsigned char* lds, const Gemm g, const Sched& S, const Epi& E) {
    const int tid = opaque_tid(), wid = __builtin_amdgcn_readfirstlane(tid >> 6), lane = tid & 63, wr = wid >> 2, wc = wid & 3, fr = lane & 15, fq = lane >> 4;
    const int K = g.K, nt = K / BK;
    unsigned voffA[2], voffB[2];
#pragma unroll
    for (int i = 0; i < 2; ++i) { int R, C; stage_rc(tid * 16 + i * 8192, R, C); const int Rb = Epi::PERM ? ((R & ~31) + perm32(R & 31)) : R;
        voffA[i] = (unsigned)(R * K + C) * 2u; voffB[i] = (unsigned)(Rb * K + C) * 2u; }
    const size_t kstep = (size_t)(BK * 2);
    const size_t hstep = (size_t)HALF * K * 2;
    const size_t tstep = 2 * hstep;
    const unsigned ldsw = (unsigned)wid * 1024u;
    const int aoff = lds_byte(wr * 64 + fr, fq * 8), boff = lds_byte(wc * 32 + fr, fq * 8);
#define PG8_SA(b, h) (((b) * 2 + (h)) * HTB)
#define PG8_SB(b, h) ((4 + (b) * 2 + (h)) * HTB)
#define PG8_STAGE(bufoff, gbase, voff) do { _Pragma("unroll") for (int _i = 0; _i < 2; ++_i) \
        __builtin_amdgcn_global_load_lds((const unsigned*)((const char*)(gbase) + (voff)[_i]), (PG8_LAS unsigned*)(lds + (bufoff) + ldsw + _i * 8192), 16, 0, 0); } while (0)
#define PG8_LDA(dst, b, h) do { _Pragma("unroll") for (int m = 0; m < 4; ++m) _Pragma("unroll") for (int k = 0; k < 2; ++k) dst[m][k] = *(const PG8_LAS bf16x8*)(lds + PG8_SA(b, h) + aoff + m * 2048 + k * 1024); } while (0)
#define PG8_LDB(dst, b, h) do { _Pragma("unroll") for (int n = 0; n < 2; ++n) _Pragma("unroll") for (int k = 0; k < 2; ++k) dst[n][k] = *(const PG8_LAS bf16x8*)(lds + PG8_SB(b, h) + boff + n * 2048 + k * 1024); } while (0)
#define PG8_MMA(ai, bj, At, Bt) do { __builtin_amdgcn_s_setprio(1); _Pragma("unroll") for (int m = 0; m < 4; ++m) _Pragma("unroll") for (int n = 0; n < 2; ++n) _Pragma("unroll") for (int k = 0; k < 2; ++k) \
        acc[ai][bj][m][n] = __builtin_amdgcn_mfma_f32_16x16x32_bf16(Bt[n][k], At[m][k], acc[ai][bj][m][n], 0, 0, 0); __builtin_amdgcn_s_setprio(0); } while (0)
#define PG8_WAIT_V(n) asm volatile("s_waitcnt vmcnt(" #n ")" ::: "memory")
#define PG8_WAIT_L(n) asm volatile("s_waitcnt lgkmcnt(" #n ")" ::: "memory")
#define PG8_BAR __builtin_amdgcn_s_barrier()
#define PG8_SCHED __builtin_amdgcn_sched_barrier(0)
    Unit cur, nxt; int ui = 0;
    if (!S.next(0, cur)) return;
    f32x4 acc[2][2][4][2];
#pragma unroll
    for (int a = 0; a < 2; ++a)
#pragma unroll
        for (int b = 0; b < 2; ++b)
#pragma unroll
            for (int m = 0; m < 4; ++m)
#pragma unroll
                for (int n = 0; n < 2; ++n) acc[a][b][m][n] = (f32x4){0.f, 0.f, 0.f, 0.f};
    bf16x8 At[4][2], B0[2][2], B1[2][2];
    const char* cA = (const char*)g.A + (size_t)cur.pm * tstep; const char* cB = (const char*)g.Bt + (size_t)cur.pn * tstep;
    S.a_ready(cur);
    if constexpr (SP2) {
        PG8_STAGE(PG8_SB(0, 0), cB, voffB); PG8_STAGE(PG8_SB(0, 1), cB + hstep, voffB); PG8_STAGE(PG8_SA(0, 0), cA, voffA); PG8_STAGE(PG8_SA(0, 1), cA + hstep, voffA);
        if (wr == 1) PG8_BAR;
        PG8_WAIT_V(2); PG8_BAR;
        PG8_STAGE(PG8_SB(1, 0), cB + kstep, voffB); PG8_STAGE(PG8_SA(1, 0), cA + kstep, voffA); PG8_STAGE(PG8_SB(1, 1), cB + hstep + kstep, voffB);
        PG8_WAIT_V(6); PG8_BAR;
    } else {
        PG8_STAGE(PG8_SB(0, 0), cB, voffB); PG8_STAGE(PG8_SA(0, 0), cA, voffA); PG8_STAGE(PG8_SB(0, 1), cB + hstep, voffB); PG8_STAGE(PG8_SA(0, 1), cA + hstep, voffA);
        if (wr == 1) PG8_BAR;
        PG8_WAIT_V(4); PG8_BAR;
        PG8_STAGE(PG8_SB(1, 0), cB + kstep, voffB); PG8_STAGE(PG8_SA(1, 0), cA + kstep, voffA); PG8_STAGE(PG8_SB(1, 1), cB + hstep + kstep, voffB);
        PG8_WAIT_V(6); PG8_BAR;
    }
    for (;;) {
        const bool has_next = S.next(ui + 1, nxt);
        const char* nA = has_next ? (const char*)g.A + (size_t)nxt.pm * tstep : cA; const char* nB = has_next ? (const char*)g.Bt + (size_t)nxt.pn * tstep : cB;
        for (int t = 0; t < nt; t += 2) {
            const bool last = (t == nt - 2);
            const char* a1 = cA + (size_t)(t + 1) * kstep;
            const char* a2 = last ? nA : cA + (size_t)(t + 2) * kstep; const char* b2 = last ? nB : cB + (size_t)(t + 2) * kstep;
            const char* a3 = a2 + kstep; const char* b3 = b2 + kstep;
            if (last && has_next) S.a_ready(nxt);
            if constexpr (SP2) {
            PG8_LDB(B0, 0, 0); PG8_LDB(B1, 0, 1); PG8_SCHED; PG8_LDA(At, 0, 0); PG8_STAGE(PG8_SA(1, 1), a1 + hstep, voffA);
            PG8_WAIT_V(8); PG8_WAIT_L(0); PG8_BAR; PG8_MMA(0, 0, At, B0); PG8_MMA(0, 1, At, B1); PG8_BAR; PG8_SCHED;
            PG8_LDA(At, 0, 1); PG8_STAGE(PG8_SB(0, 0), b2, voffB); PG8_STAGE(PG8_SB(0, 1), b2 + hstep, voffB); PG8_STAGE(PG8_SA(0, 0), a2, voffA);
            PG8_WAIT_V(8); PG8_WAIT_L(0); PG8_BAR; PG8_MMA(1, 0, At, B0); PG8_MMA(1, 1, At, B1); PG8_BAR; PG8_SCHED;
            PG8_LDB(B0, 1, 0); PG8_LDB(B1, 1, 1); PG8_SCHED; PG8_LDA(At, 1, 0); PG8_STAGE(PG8_SA(0, 1), a2 + hstep, voffA);
            PG8_WAIT_V(8); PG8_WAIT_L(0); PG8_BAR; PG8_MMA(0, 0, At, B0); PG8_MMA(0, 1, At, B1); PG8_BAR; PG8_SCHED;
            PG8_LDA(At, 1, 1); PG8_STAGE(PG8_SB(1, 0), b3, voffB); PG8_STAGE(PG8_SB(1, 1), b3 + hstep, voffB); PG8_STAGE(PG8_SA(1, 0), a3, voffA);
            PG8_WAIT_V(8); PG8_WAIT_L(0); PG8_BAR; PG8_MMA(1, 0, At, B0); PG8_MMA(1, 1, At, B1); PG8_BAR; PG8_SCHED;
            } else {
            PG8_LDB(B0, 0, 0); PG8_SCHED; PG8_LDA(At, 0, 0); PG8_STAGE(PG8_SA(1, 1), a1 + hstep, voffA);
            PG8_WAIT_L(8); PG8_BAR; PG8_WAIT_L(0); PG8_MMA(0, 0, At, B0); PG8_BAR; PG8_SCHED;
            PG8_LDB(B1, 0, 1); PG8_STAGE(PG8_SB(0, 0), b2, voffB);
            PG8_BAR; PG8_WAIT_L(0); PG8_MMA(0, 1, At, B1); PG8_BAR;
            PG8_LDA(At, 0, 1); PG8_STAGE(PG8_SA(0, 0), a2, voffA);
            PG8_BAR; PG8_WAIT_L(0); PG8_MMA(1, 0, At, B0); PG8_BAR; PG8_SCHED;
            PG8_STAGE(PG8_SB(0, 1), b2 + hstep, voffB);
            PG8_WAIT_V(6); PG8_BAR; PG8_MMA(1, 1, At, B1); PG8_BAR;
            PG8_LDB(B0, 1, 0); PG8_SCHED; PG8_LDA(At, 1, 0); PG8_STAGE(PG8_SA(0, 1), a2 + hstep, voffA);
            PG8_WAIT_L(8); PG8_BAR; PG8_WAIT_L(0); PG8_MMA(0, 0, At, B0); PG8_BAR; PG8_SCHED;
            PG8_LDB(B1, 1, 1); PG8_STAGE(PG8_SB(1, 0), b3, voffB);
            PG8_BAR; PG8_WAIT_L(0); PG8_MMA(0, 1, At, B1); PG8_BAR;
            PG8_LDA(At, 1, 1); PG8_STAGE(PG8_SA(1, 0), a3, voffA);
            PG8_BAR; PG8_WAIT_L(0); PG8_MMA(1, 0, At, B0); PG8_BAR; PG8_SCHED;
            PG8_STAGE(PG8_SB(1, 1), b3 + hstep, voffB);
            PG8_WAIT_V(6); PG8_BAR; PG8_MMA(1, 1, At, B1); PG8_BAR;
            }
        }
        if constexpr (ALIGN_EPI) { if (wr == 0) PG8_BAR; }
        if constexpr (!Epi::AFTER_DRAIN) { E(acc, cur, wr, wc, fr, fq); S.done(cur); }
        if (!has_next) break;
#pragma unroll
        for (int a = 0; a < 2; ++a)
#pragma unroll
            for (int b = 0; b < 2; ++b)
#pragma unroll
                for (int m = 0; m < 4; ++m)
#pragma unroll
                    for (int n = 0; n < 2; ++n) acc[a][b][m][n] = (f32x4){0.f, 0.f, 0.f, 0.f};
        cur = nxt; cA = nA; cB = nB; ++ui;
        if constexpr (ALIGN_EPI) { if (wr == 1) PG8_BAR; }
    }
    PG8_WAIT_V(0);
    if constexpr (!ALIGN_EPI) { if (wr == 0) PG8_BAR; }
    PG8_BAR;
    if constexpr (Epi::AFTER_DRAIN) { E.fused(acc, cur, wr, wc, fr, fq, lds, wid, lane); S.done(cur); }
#undef PG8_SA
#undef PG8_SB
#undef PG8_STAGE
#undef PG8_LDA
#undef PG8_LDB
#undef PG8_MMA
#undef PG8_WAIT_V
#undef PG8_WAIT_L
#undef PG8_BAR
#undef PG8_SCHED
}
}
namespace sba {
using bf16x8 = __attribute__((ext_vector_type(8))) short;
using s16x4 = __attribute__((ext_vector_type(4))) short;
using f32x16 = __attribute__((ext_vector_type(16))) float;
using u32x4 = __attribute__((ext_vector_type(4))) unsigned;
typedef unsigned short bf16;
constexpr int DM = 1024, KVBLK = 64, QBLK = 32, QB = 256, SLOTB = 8192;
constexpr int LDS_K = 0, LDS_V = 2 * SLOTB, LDS_OST = 4 * SLOTB, LDS_BYTES = LDS_OST + 8 * 4096;
__device__ __forceinline__ int crow(int r, int hi) { return (r & 3) + 8 * (r >> 2) + 4 * hi; }
__device__ __forceinline__ void glds16(const void* gsrc, unsigned lds_dst) { unsigned keep;
    asm volatile("s_mov_b32 %0, m0\n\ts_mov_b32 m0, %2\n\ts_nop 0\n\tglobal_load_lds_dwordx4 %1, off\n\ts_mov_b32 m0, %0" : "=&s"(keep) : "v"(gsrc), "s"(lds_dst) : "memory"); }
typedef float f32x2_t __attribute__((ext_vector_type(2))); typedef __bf16 bf16x2_t __attribute__((ext_vector_type(2)));
__device__ __forceinline__ unsigned cvtpk_s(float lo, float hi) { f32x2_t v = {lo, hi}; bf16x2_t b = __builtin_convertvector(v, bf16x2_t); return __builtin_bit_cast(unsigned, b); }
#define SBA_WAIT_BAR() asm volatile("s_waitcnt vmcnt(0) lgkmcnt(0)\n\ts_barrier" ::: "memory")
typedef __attribute__((address_space(3))) const char* lds_cptr;

__device__ __forceinline__ void qkt(f32x16& p0, f32x16& p1, lds_cptr Kslot, const bf16x8* qr, int r32, int hi) {
    lds_cptr kb = Kslot + hi * 1024 + r32 * 16;
    const f32x16 z = f32x16{};
#pragma unroll
    for (int d0 = 0; d0 < 4; ++d0) {
        const bf16x8 b0 = *(const __attribute__((address_space(3))) bf16x8*)(kb + d0 * 2048);
        const bf16x8 b1 = *(const __attribute__((address_space(3))) bf16x8*)(kb + d0 * 2048 + 512);
        if (d0 == 0) { p0 = __builtin_amdgcn_mfma_f32_32x32x16_bf16(b0, qr[0], z, 0, 0, 0); p1 = __builtin_amdgcn_mfma_f32_32x32x16_bf16(b1, qr[0], z, 0, 0, 0); }
        else { p0 = __builtin_amdgcn_mfma_f32_32x32x16_bf16(b0, qr[d0], p0, 0, 0, 0); p1 = __builtin_amdgcn_mfma_f32_32x32x16_bf16(b1, qr[d0], p1, 0, 0, 0); } }
}
__device__ __forceinline__ void pv(f32x16* o, int vb, bf16x8 pa0, bf16x8 pa1, bf16x8 pa2, bf16x8 pa3) {
#pragma unroll
    for (int d0 = 0; d0 < 2; ++d0) { s16x4 lo[4], hi[4];
#pragma unroll
        for (int ks = 0; ks < 4; ++ks) {
            asm volatile("ds_read_b64_tr_b16 %0,%1 offset:%c2" : "=&v"(lo[ks]) : "v"(vb), "i"(d0 * 4096 + ks * 1024) : "memory");
            asm volatile("ds_read_b64_tr_b16 %0,%1 offset:%c2" : "=&v"(hi[ks]) : "v"(vb), "i"(d0 * 4096 + ks * 1024 + 512) : "memory"); }
        asm volatile("s_waitcnt lgkmcnt(0)" ::: "memory"); __builtin_amdgcn_sched_barrier(0);
#define SBA_PK(k) (bf16x8){lo[k][0], lo[k][1], lo[k][2], lo[k][3], hi[k][0], hi[k][1], hi[k][2], hi[k][3]}
        o[d0] = __builtin_amdgcn_mfma_f32_32x32x16_bf16(pa0, SBA_PK(0), o[d0], 0, 0, 0);
        o[d0] = __builtin_amdgcn_mfma_f32_32x32x16_bf16(pa1, SBA_PK(1), o[d0], 0, 0, 0);
        o[d0] = __builtin_amdgcn_mfma_f32_32x32x16_bf16(pa2, SBA_PK(2), o[d0], 0, 0, 0);
        o[d0] = __builtin_amdgcn_mfma_f32_32x32x16_bf16(pa3, SBA_PK(3), o[d0], 0, 0, 0);
#undef SBA_PK
    }
}

__device__ __forceinline__ void sb_weights(f32x16& p0, f32x16& p1, float& carry, int hi, int qk, bool diag) {
    f32x16 k0v, k1v;
#pragma unroll
    for (int r = 0; r < 16; ++r) {
        const float e0 = __builtin_amdgcn_exp2f(__builtin_fminf(p0[r], 64.f)), e1 = __builtin_amdgcn_exp2f(__builtin_fminf(p1[r], 64.f));
        float kp0 = __builtin_amdgcn_rcpf(1.0f + e0), kp1 = __builtin_amdgcn_rcpf(1.0f + e1);
        float sg0 = e0 * kp0, sg1 = e1 * kp1;
        if (diag) { const int kk = crow(r, hi); if (kk >= qk) { kp0 = 1.f; sg0 = 0.f; } if (kk + 32 >= qk) { kp1 = 1.f; sg1 = 0.f; } }
        k0v[r] = kp0; k1v[r] = kp1; p0[r] = sg0; p1[r] = sg1;
    }
    float R = carry;
#define SBA_GROUP(P, KV, g) do { \
        const float q2 = KV[4 * (g) + 3], q1 = q2 * KV[4 * (g) + 2], q0 = q1 * KV[4 * (g) + 1], gp = q0 * KV[4 * (g)]; \
        const unsigned own = __float_as_uint(gp); auto rr = __builtin_amdgcn_permlane32_swap(own, own, false, false); \
        const float other = __uint_as_float(rr[0] ^ rr[1] ^ own), pairp = __uint_as_float(rr[0]) * __uint_as_float(rr[1]); \
        const float rin = hi ? R : R * other; \
        P[4 * (g) + 3] *= rin; P[4 * (g) + 2] *= rin * q2; P[4 * (g) + 1] *= rin * q1; P[4 * (g)] *= rin * q0; \
        R *= pairp; } while (0)
    SBA_GROUP(p1, k1v, 3); SBA_GROUP(p1, k1v, 2); SBA_GROUP(p1, k1v, 1); SBA_GROUP(p1, k1v, 0);
    SBA_GROUP(p0, k0v, 3); SBA_GROUP(p0, k0v, 2); SBA_GROUP(p0, k0v, 1); SBA_GROUP(p0, k0v, 0);
#undef SBA_GROUP
    carry = R;
}

__device__ __forceinline__ void attn_unit(int b, int h, int qb, const bf16* Q, const bf16* K, const bf16* V, bf16* O, __attribute__((address_space(3))) char* shm) {
    const int tid = opaque_tid(), lane = tid & 63, r32 = lane & 31, hi = lane >> 5; const int wid = __builtin_amdgcn_readfirstlane(tid >> 6);
    const long rowbase = (long)b * SEQ; const int q0 = qb * QB;
    const bf16* Qw = Q + (rowbase + q0 + wid * QBLK) * DM + h * HD;
    const bf16* Kh = K + rowbase * DM + h * HD, * Vh = V + rowbase * DM + h * HD;
    const unsigned lds0 = (unsigned)(uintptr_t)shm;
    const bf16* ksrc = Kh + (long)lane * DM + wid * 8;
    const bf16* vsrc = Vh + (long)(16 * (wid & 3) + (lane >> 2)) * DM + (wid >> 2) * 32 + (lane & 3) * 8;
    const unsigned kdst = lds0 + LDS_K + wid * 1024, vdst = lds0 + LDS_V + wid * 1024;
#define SBA_DMA_K(t, slot) glds16(ksrc + (long)(t) * KVBLK * DM, (unsigned)__builtin_amdgcn_readfirstlane(kdst + (slot)))
#define SBA_DMA_V(t, slot) glds16(vsrc + (long)(t) * KVBLK * DM, (unsigned)__builtin_amdgcn_readfirstlane(vdst + (slot)))
    const int vb0 = (int)(lds0 + LDS_V) + ((lane >> 4) & 1) * 32 + (lane & 3) * 8 + (4 * hi + ((lane & 15) >> 2)) * 64;
    const lds_cptr shm3 = (lds_cptr)shm;
    const int NT = (q0 + QB) / KVBLK;
    SBA_DMA_K(NT - 1, 0); SBA_DMA_V(NT - 1, 0);
    bf16x8 qr[4];
#pragma unroll
    for (int d0 = 0; d0 < 4; ++d0) qr[d0] = *reinterpret_cast<const bf16x8*>(&Qw[(long)r32 * DM + d0 * 16 + hi * 8]);
    f32x16 o[2]; o[0] = f32x16{}; o[1] = f32x16{};
    float carry = 1.0f;
    const int qw0 = q0 + wid * QBLK;
    int slot = 0;
    for (int t = NT - 1; t >= 0; --t) {
        SBA_WAIT_BAR();
        if (t > 0) { SBA_DMA_K(t - 1, slot ^ SLOTB); SBA_DMA_V(t - 1, slot ^ SLOTB); }
        if (64 * t <= qw0) {
            f32x16 p0, p1;
            qkt(p0, p1, shm3 + LDS_K + slot, qr, r32, hi);
            sb_weights(p0, p1, carry, hi, qw0 + r32 - 64 * t, 64 * t + 64 > qw0);
            u32x4 pw0, pw1, pw2, pw3;
            pw0 = (u32x4){cvtpk_s(p0[0], p0[1]), cvtpk_s(p0[2], p0[3]), cvtpk_s(p0[4], p0[5]), cvtpk_s(p0[6], p0[7])};
            pw1 = (u32x4){cvtpk_s(p0[8], p0[9]), cvtpk_s(p0[10], p0[11]), cvtpk_s(p0[12], p0[13]), cvtpk_s(p0[14], p0[15])};
            pw2 = (u32x4){cvtpk_s(p1[0], p1[1]), cvtpk_s(p1[2], p1[3]), cvtpk_s(p1[4], p1[5]), cvtpk_s(p1[6], p1[7])};
            pw3 = (u32x4){cvtpk_s(p1[8], p1[9]), cvtpk_s(p1[10], p1[11]), cvtpk_s(p1[12], p1[13]), cvtpk_s(p1[14], p1[15])};
            __builtin_amdgcn_sched_barrier(0);
            pv(o, vb0 + slot, __builtin_bit_cast(bf16x8, pw0), __builtin_bit_cast(bf16x8, pw1), __builtin_bit_cast(bf16x8, pw2), __builtin_bit_cast(bf16x8, pw3));
        }
        slot ^= SLOTB;
    }
    bf16* Ow = O + (rowbase + q0 + wid * QBLK) * DM + h * HD;
    { __attribute__((address_space(3))) bf16* stg = (__attribute__((address_space(3))) bf16*)(shm3 + LDS_OST) + wid * 2048;
#pragma unroll
      for (int r = 0; r < 16; ++r) { const int orow = crow(r, hi);
#pragma unroll
        for (int d0 = 0; d0 < 2; ++d0) { const unsigned pk = cvtpk_s(o[d0][r], 0.f); stg[orow * 64 + d0 * 32 + r32] = (bf16)(pk & 0xffffu); } }
      asm volatile("s_waitcnt lgkmcnt(0)" ::: "memory");
#pragma unroll
      for (int i = 0; i < 4; ++i) { const int row = i * 8 + (lane >> 3), ch = lane & 7; const u32x4 v = *(const __attribute__((address_space(3))) u32x4*)(stg + row * 64 + ch * 8); *(u32x4*)(Ow + (long)row * DM + ch * 8) = v; } }
    asm volatile("s_waitcnt lgkmcnt(0)\n\ts_barrier" ::: "memory");
#undef SBA_DMA_K
#undef SBA_DMA_V
}
#undef SBA_WAIT_BAR
}

#define GAS __attribute__((address_space(1)))
#define LAS __attribute__((address_space(3)))
typedef unsigned short bf16;
typedef unsigned v4u __attribute__((ext_vector_type(4)));
typedef unsigned v2u __attribute__((ext_vector_type(2)));
typedef float f32x4 __attribute__((ext_vector_type(4)));
typedef short bf16x8 __attribute__((ext_vector_type(8)));
typedef GAS unsigned gu32;
#define RLX_AGENT __ATOMIC_RELAXED, __HIP_MEMORY_SCOPE_AGENT
#define LDS_WAIT() asm volatile("s_waitcnt lgkmcnt(0)" ::: "memory")
#define VM_WAIT() asm volatile("s_waitcnt vmcnt(0)" ::: "memory")
constexpr int NWAVES = 8;

constexpr size_t MiB = 1u << 20;
constexpr size_t WS_CTL = 0, CTL_ZERO_BYTES = 1 * MiB;
constexpr size_t WS_MOD = 1 * MiB;
constexpr size_t WS_SA = 2 * MiB, WS_SB = 3 * MiB;
constexpr size_t WS_WGU = 4 * MiB;
constexpr size_t WS_WDN = 48 * MiB;
constexpr size_t WS_WQKV = 70 * MiB, WS_WO = 76 * MiB, WS_WIN = 78 * MiB, WS_WOUT = 83 * MiB, WS_WRI = 86 * MiB;
constexpr size_t WS_XN = 88 * MiB;
constexpr size_t WS_OV = 120 * MiB;
constexpr size_t WS_ACT = WS_OV, WS_QO = WS_OV, WS_K = WS_OV + 32 * MiB, WS_V = WS_OV + 64 * MiB, WS_GG = WS_OV, WS_XB = WS_OV + 40 * MiB;
constexpr size_t WS_END = 240 * MiB;
constexpr size_t WS_SCR = 256 * MiB, WS_SCR_END = 320 * MiB;
static_assert(WS_WGU + 4 * (size_t)NGU * D * 2 <= WS_WDN && WS_WDN + 4 * (size_t)D * FF * 2 <= WS_WQKV && WS_WQKV + (size_t)NQKV * D * 2 <= WS_WO && WS_WO + (size_t)D * D * 2 <= WS_WIN &&
              WS_WIN + (size_t)NIN * D * 2 <= WS_WOUT && WS_WOUT + (size_t)D * DR * 2 <= WS_WRI && WS_WRI + 10 * 256 * 128 * 2 <= WS_XN && WS_XN + (size_t)M * D * 2 <= WS_OV &&
              WS_ACT + (size_t)M * FF * 2 <= WS_END && WS_V + (size_t)M * D * 2 <= WS_END && WS_XB + (size_t)M * DR * 4 <= WS_END && WS_GG + (size_t)M * DR * 2 <= WS_XB, "d_ws map");
constexpr int CW_BAR = 4096;

constexpr int RING_OFF = 0, RING_BYTES = 131072;
constexpr int LDS_BYTES = 155648;
constexpr int MISC_OFF = LDS_BYTES - 256;

__device__ __forceinline__ unsigned f2bf(float f) { unsigned u = __builtin_bit_cast(unsigned, f); return (u + 0x7fffu + ((u >> 16) & 1u)) >> 16; }
__device__ __forceinline__ unsigned pk2(float lo, float hi) { return f2bf(lo) | (f2bf(hi) << 16); }
__device__ __forceinline__ float bf2f(unsigned short b) { return __builtin_bit_cast(float, (unsigned)b << 16); }

#define XB_TMO      128
#define XB_XCNT(j)  (256  + 64 * (j))
#define XB_XSUB(j)  (1280 + 64 * (j))
#define XB_XGEN(j)  (2304 + 64 * (j))
#define XB_TOP      3328
#define XB_TOPGEN   3392
#define XCD_BAR_WORDS 3456
#define XB_SPIN_CAP (1u << 18)
__device__ __forceinline__ unsigned xb_ld(unsigned* p)              { return __hip_atomic_load(p, __ATOMIC_RELAXED, __HIP_MEMORY_SCOPE_AGENT); }
__device__ __forceinline__ unsigned xb_add(unsigned* p, unsigned v) { return __hip_atomic_fetch_add(p, v, __ATOMIC_RELAXED, __HIP_MEMORY_SCOPE_AGENT); }
__device__ __forceinline__ unsigned xb_xcc_id() { return (unsigned)__builtin_amdgcn_s_getreg((3 << 11) | 20) & 0xFu; }
#define XB_SPIN(cond, bar) do { unsigned _sp = 0; while (cond) { __builtin_amdgcn_s_sleep(1); \
    if ((++_sp & 255u) == 0u) { if (xb_ld(&(bar)[XB_TMO])) break; if (_sp > XB_SPIN_CAP) { atomicAdd(&(bar)[XB_TMO], 1u); break; } } } } while (0)
struct XcdBarrier { unsigned* bar; unsigned x; volatile LAS unsigned* st; };
__device__ __forceinline__ XcdBarrier xcd_barrier_post(unsigned* bar, volatile LAS unsigned* st) {
    XcdBarrier b; b.bar = bar; b.x = xb_xcc_id(); b.st = st;
    if (threadIdx.x == 0) (void)xb_add(&bar[XB_XCNT(b.x)], 1u);
    return b;
}
__device__ __forceinline__ void xcd_barrier_complete(unsigned* bar, unsigned x, unsigned& nloc, unsigned& nx) {
    const unsigned G = gridDim.x * gridDim.y * gridDim.z;
    unsigned sum, cnt, mine, sp = 0u;
    for (;;) {
        sum = 0u; cnt = 0u; mine = 0u;
#pragma unroll
        for (unsigned j = 0; j < 16; ++j) { const unsigned c = xb_ld(&bar[XB_XCNT(j)]); sum += c; cnt += (c > 0u) ? 1u : 0u; mine = (j == x) ? c : mine; }
        if (sum == G) break;
        __builtin_amdgcn_s_sleep(1);
        if ((++sp & 255u) == 0u) { if (xb_ld(&bar[XB_TMO])) break; if (sp > XB_SPIN_CAP) { atomicAdd(&bar[XB_TMO], 1u); break; } }
    }
    nloc = mine > 0u ? mine : 1u; nx = cnt > 0u ? cnt : 1u;
}
__device__ __forceinline__ void xcd_barrier(const XcdBarrier& b) {
    asm volatile("s_waitcnt vmcnt(0)" ::: "memory");
    __syncthreads();
    if (threadIdx.x == 0) {
        GAS unsigned* barg = (GAS unsigned*)b.bar; asm volatile("" : "+s"(barg)); unsigned* bar = (unsigned*)barg;
        __builtin_amdgcn_s_waitcnt(0);
        unsigned nloc = b.st[0], nx = b.st[1];
        if (nloc == 0u) { xcd_barrier_complete(bar, b.x, nloc, nx); b.st[0] = nloc; b.st[1] = nx; }
        const unsigned old = xb_add(&bar[XB_XSUB(b.x)], 1u);
        const unsigned gen = old / nloc;
        if (old + 1u == (gen + 1u) * nloc) {
            __builtin_amdgcn_fence(__ATOMIC_RELEASE, "agent");
            asm volatile("s_waitcnt vmcnt(0)" ::: "memory");
            const unsigned og = xb_add(&bar[XB_TOP], 1u);
            const unsigned tg = og / nx;
            if (og + 1u == (tg + 1u) * nx) xb_add(&bar[XB_TOPGEN], 1u);
            else XB_SPIN(xb_ld(&bar[XB_TOPGEN]) == tg, bar);
            __builtin_amdgcn_fence(__ATOMIC_ACQUIRE, "agent");
            xb_add(&bar[XB_XGEN(b.x)], 1u);
            asm volatile("s_waitcnt vmcnt(0)" ::: "memory");
        } else {
            XB_SPIN(xb_ld(&bar[XB_XGEN(b.x)]) == gen, bar);
            __builtin_amdgcn_fence(__ATOMIC_ACQUIRE, "agent");
            asm volatile("s_waitcnt vmcnt(0)" ::: "memory");
        }
    }
    __syncthreads();
}

struct Args { const float* in[19]; float* out; unsigned char* ws; int ph_lo, ph_hi, use_bar, dup; };

__device__ __forceinline__ float wave_sum(float v) {
#pragma unroll
    for (int o = 1; o < 64; o <<= 1) v += __shfl_xor(v, o);
    return v;
}

__device__ __forceinline__ void tr_tile(const float* src, int lds_, bf16* dst, int ldd, LAS float* scr, int lane) {
#pragma unroll 8
    for (int i = 0; i < 32; ++i) { const int kk = 2 * i + (lane >> 5); scr[kk * 33 + (lane & 31)] = src[(size_t)kk * lds_ + (lane & 31)]; }
    LDS_WAIT(); asm volatile("" ::: "memory");
    const int c = lane & 7;
#pragma unroll
    for (int j = 0; j < 4; ++j) { const int n = (lane >> 3) + 8 * j; const LAS float* s = scr + (8 * c) * 33 + n;
        v4u o; o.x = pk2(s[0 * 33], s[1 * 33]); o.y = pk2(s[2 * 33], s[3 * 33]); o.z = pk2(s[4 * 33], s[5 * 33]); o.w = pk2(s[6 * 33], s[7 * 33]);
        *(GAS v4u*)(dst + (size_t)n * ldd + 8 * c) = o; }
    LDS_WAIT(); asm volatile("" ::: "memory");
}
__device__ __forceinline__ void tr_plain(const float* W, int K, int N, bf16* WT, LAS float* scr, int item, int lane) {
    const int nblk = N / 32, kb = item / nblk, nb = item % nblk, k0 = 64 * kb, n0 = 32 * nb;
    tr_tile(W + (size_t)k0 * N + n0, N, WT + (size_t)n0 * K + k0, K, scr, lane);
}
__device__ __forceinline__ void p0_prologue(const Args& a, unsigned char* ws, LAS unsigned char* lds, int vcu, int G, int tid, int lane, int wave) {
    LAS float* scr = (LAS float*)(lds + wave * 8448);
    const int gw = vcu * NWAVES + wave, NGW = G * NWAVES;
    constexpr int I_GU = (D / 64) * (NGU / 32), I_DN = (FF / 64) * (D / 32), I_QKV = (D / 64) * (NQKV / 32), I_O = (D / 64) * (D / 32), I_IN = (D / 64) * (NIN / 32), I_OUT = (DR / 64) * (D / 32), I_G = 2 * 4;
    constexpr int NITEMS = 4 * I_GU + 4 * I_DN + I_QKV + I_O + I_IN + I_OUT + 20 * I_G;
    for (int it = gw; it < NITEMS; it += NGW) {
        int r = it;
        if (r < 4 * I_GU) {
            const int mat = r / I_GU, item = r % I_GU; const int nblk = NGU / 32, kb = item / nblk, nb = item % nblk, k0 = 64 * kb, n0 = 32 * nb;
            const int isu = n0 >= FF ? 1 : 0, ff0 = n0 - isu * FF, L0 = (ff0 >> 7) * 256 + isu * 128 + (ff0 & 127);
            const float* W = a.in[5] + (size_t)mat * D * NGU; bf16* WT = (bf16*)(ws + WS_WGU) + (size_t)mat * NGU * D;
            tr_tile(W + (size_t)k0 * NGU + n0, NGU, WT + (size_t)L0 * D + k0, D, scr, lane); continue; }
        r -= 4 * I_GU;
        if (r < 4 * I_DN) { const int mat = r / I_DN; tr_plain(a.in[6] + (size_t)mat * FF * D, FF, D, (bf16*)(ws + WS_WDN) + (size_t)mat * D * FF, scr, r % I_DN, lane); continue; }
        r -= 4 * I_DN;
        if (r < I_QKV) { tr_plain(a.in[7], D, NQKV, (bf16*)(ws + WS_WQKV), scr, r, lane); continue; } r -= I_QKV;
        if (r < I_O) { tr_plain(a.in[8], D, D, (bf16*)(ws + WS_WO), scr, r, lane); continue; } r -= I_O;
        if (r < I_IN) { tr_plain(a.in[9], D, NIN, (bf16*)(ws + WS_WIN), scr, r, lane); continue; } r -= I_IN;
        if (r < I_OUT) { tr_plain(a.in[17], DR, D, (bf16*)(ws + WS_WOUT), scr, r, lane); continue; } r -= I_OUT;
        { const int mat = r / I_G, item = r % I_G, n = mat >> 1, isi = mat & 1;
          tr_plain((isi ? a.in[14] : a.in[12]) + (size_t)n * 128 * 128, 128, 128, (bf16*)(ws + WS_WRI) + (size_t)n * 256 * 128 + (size_t)isi * 128 * 128, scr, item, lane); }
    }
    __syncthreads();
    LAS float* ca = (LAS float*)lds;
    LAS float* part = (LAS float*)(lds + 32768);
    for (int i = tid; i < BATCH * D; i += NWAVES * 64) { const int b = i / D, k = i % D; const float c = a.in[1][i]; ca[k * 8 + b] = c * __builtin_amdgcn_rcpf(1.0f + __builtin_amdgcn_exp2f(-c * LOG2E)); }
    __syncthreads();
    float* MOD = (float*)(ws + WS_MOD);
    for (int ch = vcu; ch < 2 * NMOD / 72; ch += G) {
        const int g0 = ch * 72, l = g0 / NMOD, j0 = g0 % NMOD;
        const float* W = a.in[2] + (size_t)l * D * NMOD + j0;
        const int rs = lane / 18, cg = lane % 18;
        f32x4 acc[8];
#pragma unroll
        for (int b = 0; b < 8; ++b) acc[b] = (f32x4){0.f, 0.f, 0.f, 0.f};
        if (rs < 3) {
#pragma unroll 4
            for (int i = 0; i < 43; ++i) { const int kl = 3 * i + rs; if (kl < 128) { const int k = wave * 128 + kl;
                const f32x4 w = *(const f32x4*)(W + (size_t)k * NMOD + 4 * cg);
                const f32x4 c0 = *(const LAS f32x4*)(ca + k * 8), c1 = *(const LAS f32x4*)(ca + k * 8 + 4);
                acc[0] += w * c0[0]; acc[1] += w * c0[1]; acc[2] += w * c0[2]; acc[3] += w * c0[3]; acc[4] += w * c1[0]; acc[5] += w * c1[1]; acc[6] += w * c1[2]; acc[7] += w * c1[3]; } }
#pragma unroll
            for (int b = 0; b < 8; ++b) *(LAS f32x4*)(part + ((wave * 3 + rs) * 8 + b) * 72 + 4 * cg) = acc[b];
        }
        __syncthreads();
        for (int o = tid; o < 8 * 72; o += NWAVES * 64) { const int b = o / 72, j = o % 72; float s = a.in[3][(size_t)l * NMOD + j0 + j];
#pragma unroll
            for (int p = 0; p < 24; ++p) s += part[(p * 8 + b) * 72 + j];
            MOD[((size_t)l * BATCH + b) * NMOD + j0 + j] = s; }
        __syncthreads();
    }
}

__device__ __forceinline__ void norm_mod_phase(const float* x, const float* g, const float* shift, const float* scale, bf16* XN, int vcu, int G, int lane, int wave) {
    const int gw = vcu * NWAVES + wave, NGW = G * NWAVES;
    for (int blk = gw; blk < M / 8; blk += NGW) {
        const int row0 = blk * 8, b = row0 / SEQ;
        f32x4 gs[4], sh[4];
#pragma unroll
        for (int j = 0; j < 4; ++j) { const int c = 4 * lane + 256 * j; gs[j] = *(const f32x4*)(g + c) * (*(const f32x4*)(scale + (size_t)b * NMOD + c) + 1.0f); sh[j] = *(const f32x4*)(shift + (size_t)b * NMOD + c); }
#pragma unroll 2
        for (int r = 0; r < 8; ++r) {
            const f32x4* xr = (const f32x4*)(x + (size_t)(row0 + r) * D) + lane;
            f32x4 v[4]; float s = 0.f;
#pragma unroll
            for (int j = 0; j < 4; ++j) { v[j] = xr[64 * j]; s += (v[j].x * v[j].x + v[j].y * v[j].y) + (v[j].z * v[j].z + v[j].w * v[j].w); }
            const float inv = 1.0f / sqrtf(wave_sum(s) * (1.f / D) + RMS_EPS);
            v2u* o8 = (v2u*)(XN + (size_t)(row0 + r) * D) + lane;
#pragma unroll
            for (int j = 0; j < 4; ++j) { const f32x4 h = v[j] * inv * gs[j] + sh[j]; v2u w; w.x = pk2(h.x, h.y); w.y = pk2(h.z, h.w); o8[64 * j] = w; }
        }
    }
}
__device__ __forceinline__ void final_norm_phase(const float* x, const float* g, float* out, int vcu, int G, int lane, int wave) {
    const int gw = vcu * NWAVES + wave, NGW = G * NWAVES;
    f32x4 gs[4];
#pragma unroll
    for (int j = 0; j < 4; ++j) gs[j] = *(const f32x4*)(g + 4 * lane + 256 * j);
    for (int row = gw; row < M; row += NGW) {
        const f32x4* xr = (const f32x4*)(x + (size_t)row * D) + lane;
        f32x4 v[4]; float s = 0.f;
#pragma unroll
        for (int j = 0; j < 4; ++j) { v[j] = xr[64 * j]; s += (v[j].x * v[j].x + v[j].y * v[j].y) + (v[j].z * v[j].z + v[j].w * v[j].w); }
        const float inv = 1.0f / sqrtf(wave_sum(s) * (1.f / D) + RMS_EPS);
        f32x4* o = (f32x4*)(out + (size_t)row * D) + lane;
#pragma unroll
        for (int j = 0; j < 4; ++j) o[64 * j] = v[j] * inv * gs[j];
    }
}

namespace lru {
constexpr int WSTR = 272;
constexpr int OFF_W = 0;
constexpr int OFF_XT = OFF_W + 256 * WSTR;
constexpr int OFF_AT = OFF_XT + 35 * 512;
constexpr int OFF_XC = OFF_AT + 32 * WSTR;
constexpr int OFF_A = OFF_XC + 32 * 512;
constexpr int OFF_B = OFF_A + 32 * 512;
constexpr int OFF_P = OFF_B + 32 * 512;
constexpr int LDS_END = OFF_P + 8 * 512;
static_assert(LDS_END <= MISC_OFF, "lru LDS map");

template <int PASS> __device__ __forceinline__ void lru_pass(const Args& a, unsigned char* ws, bf16* Yout, LAS unsigned char* lds, int id0, int id1, int tid, int lane, int wave) {
    float* XB = (float*)(ws + WS_XB); const bf16* GG = (const bf16*)(ws + WS_GG); float* SA = (float*)(ws + WS_SA); float* SB = (float*)(ws + WS_SB);
    LAS float* XT = (LAS float*)(lds + OFF_XT); LAS float* XC = (LAS float*)(lds + OFF_XC); LAS float* Aa = (LAS float*)(lds + OFF_A); LAS float* Bb = (LAS float*)(lds + OFF_B); LAS float* P = (LAS float*)(lds + OFF_P);
    int ncur = -1;
    for (int id = id0; id < id1; ++id) {
        const int n = id >> 7, chunk = id & 127;
        const int seq0 = (chunk >> 4) * SEQ;
        const float* xcol = XB + n * 128;
#define LRU_LOADX(dst, r0_) do { _Pragma("unroll") for (int q = 0; q < 3; ++q) { const int i = tid + 512 * q; dst[q] = (f32x4){0.f, 0.f, 0.f, 0.f}; \
            if (i < 35 * 32) { const int grow = (r0_) - 3 + (i >> 5); if (grow >= seq0) dst[q] = *(const f32x4*)(xcol + (size_t)grow * DR + 4 * (i & 31)); } } } while (0)
#define LRU_STOREX(src) do { _Pragma("unroll") for (int q = 0; q < 3; ++q) { const int i = tid + 512 * q; if (i < 35 * 32) *(LAS f32x4*)(XT + (i >> 5) * 128 + 4 * (i & 31)) = src[q]; } } while (0)
        f32x4 xr[3]; v4u gcur = (v4u){0u, 0u, 0u, 0u}, gnext = (v4u){0u, 0u, 0u, 0u};
        const int yrow = tid >> 4, yc8 = (tid & 15) * 8;
        LRU_LOADX(xr, chunk * 128);
        if (PASS == 2) gcur = *(const v4u*)(GG + (size_t)(chunk * 128 + yrow) * DR + n * 128 + yc8);
        if (n != ncur) {
            const bf16* Wg = (const bf16*)(ws + WS_WRI) + (size_t)n * 256 * 128;
            for (int i = tid; i < 256 * 16; i += NWAVES * 64) { const int row = i >> 4, c16 = i & 15; *(LAS v4u*)(lds + OFF_W + row * WSTR + c16 * 16) = *(const v4u*)(Wg + row * 128 + c16 * 8); }
            if (tid < 128) { const int ch = n * 128 + tid;
                P[0 * 128 + tid] = a.in[10][0 * DR + ch]; P[1 * 128 + tid] = a.in[10][1 * DR + ch]; P[2 * 128 + tid] = a.in[10][2 * DR + ch]; P[3 * 128 + tid] = a.in[10][3 * DR + ch];
                P[4 * 128 + tid] = a.in[11][ch]; P[5 * 128 + tid] = a.in[13][ch] * LOG2E; P[6 * 128 + tid] = a.in[15][ch] * LOG2E; P[7 * 128 + tid] = 8.0f * log1pf(expf(-a.in[16][ch])); }
            ncur = n;
        }
        float h = 0.f, Ac = 1.f;
        if (PASS == 2 && tid < 128) { const int cs = chunk & 15, c0 = chunk - cs;
            for (int c = 0; c < cs; ++c) { const size_t idx = (size_t)(c0 + c) * DR + n * 128 + tid; h = SA[idx] * h + SB[idx]; } }
        LRU_STOREX(xr);
        LRU_LOADX(xr, chunk * 128 + 32);
        __syncthreads();
#pragma unroll 1
        for (int sub = 0; sub < 4; ++sub) {
            const int r0 = chunk * 128 + sub * 32;
            if (PASS == 2 && sub < 3) gnext = *(const v4u*)(GG + (size_t)(r0 + 32 + yrow) * DR + n * 128 + yc8);
            { const int row = tid >> 4, c8 = (tid & 15) * 8; float xc[8];
#pragma unroll
              for (int e = 0; e < 8; ++e) { const int ch = c8 + e; float s = P[4 * 128 + ch];
#pragma unroll
                  for (int tap = 0; tap < 4; ++tap) s += XT[(row + tap) * 128 + ch] * P[tap * 128 + ch];
                  xc[e] = s; }
              *(LAS f32x4*)(XC + row * 128 + c8) = (f32x4){xc[0], xc[1], xc[2], xc[3]}; *(LAS f32x4*)(XC + row * 128 + c8 + 4) = (f32x4){xc[4], xc[5], xc[6], xc[7]};
              v4u o; o.x = pk2(xc[0], xc[1]); o.y = pk2(xc[2], xc[3]); o.z = pk2(xc[4], xc[5]); o.w = pk2(xc[6], xc[7]);
              *(LAS v4u*)(lds + OFF_AT + row * WSTR + c8 * 2) = o; }
            __syncthreads();
            if (sub < 3) { LRU_STOREX(xr); if (sub < 2) LRU_LOADX(xr, r0 + 64); }
            { const int rg = wave & 1, cq = wave >> 1, fr = lane & 15, fq = lane >> 4;
              f32x4 acc[4];
#pragma unroll
              for (int t = 0; t < 4; ++t) acc[t] = (f32x4){0.f, 0.f, 0.f, 0.f};
#pragma unroll
              for (int ks = 0; ks < 4; ++ks) { const bf16x8 af = *(const LAS bf16x8*)(lds + OFF_AT + (16 * rg + fr) * WSTR + (32 * ks + 8 * fq) * 2);
#pragma unroll
                  for (int t = 0; t < 4; ++t) { const int orow = (t >> 1) * 128 + 32 * cq + 16 * (t & 1) + fr; const bf16x8 bfg = *(const LAS bf16x8*)(lds + OFF_W + orow * WSTR + (32 * ks + 8 * fq) * 2);
                      acc[t] = __builtin_amdgcn_mfma_f32_16x16x32_bf16(bfg, af, acc[t], 0, 0, 0); } }
              const int row = 16 * rg + fr;
#pragma unroll
              for (int tt = 0; tt < 2; ++tt) { const int ch0 = 32 * cq + 16 * tt + 4 * fq;
                  const f32x4 br = *(const LAS f32x4*)(P + 5 * 128 + ch0), bi = *(const LAS f32x4*)(P + 6 * 128 + ch0), sp = *(const LAS f32x4*)(P + 7 * 128 + ch0), xcv = *(const LAS f32x4*)(XC + row * 128 + ch0);
                  f32x4 av, bv;
#pragma unroll
                  for (int e = 0; e < 4; ++e) {
                      const float r = __builtin_amdgcn_rcpf(1.0f + __builtin_amdgcn_exp2f(-(acc[tt][e] * LOG2E + br[e]))), ig = __builtin_amdgcn_rcpf(1.0f + __builtin_amdgcn_exp2f(-(acc[2 + tt][e] * LOG2E + bi[e])));
                      const float la = -r * sp[e], aa = __builtin_amdgcn_exp2f(la * LOG2E), t = 2.0f * la;
                      const float em_small = -t * (1.0f + t * (0.5f + t * (0.16666667f + t * (0.041666668f + t * 0.0083333338f)))), em = (t > -0.25f) ? em_small : (1.0f - aa * aa);
                      av[e] = aa; bv[e] = __builtin_amdgcn_sqrtf(em) * (ig * xcv[e]); }
                  *(LAS f32x4*)(Aa + row * 128 + ch0) = av; *(LAS f32x4*)(Bb + row * 128 + ch0) = bv; } }
            __syncthreads();
            if (tid < 128) {
#pragma unroll 8
                for (int r = 0; r < 32; ++r) { const float av = Aa[r * 128 + tid], bv = Bb[r * 128 + tid]; h = av * h + bv; Ac *= av; if (PASS == 2) Bb[r * 128 + tid] = h; } }
            if (PASS == 2) {
                __syncthreads();
                const LAS float* hp = Bb + yrow * 128 + yc8; const f32x4 h0 = *(const LAS f32x4*)hp, h1 = *(const LAS f32x4*)(hp + 4);
                v4u o;
                o.x = pk2(bf2f((unsigned short)(gcur.x & 0xffffu)) * h0[0], bf2f((unsigned short)(gcur.x >> 16)) * h0[1]); o.y = pk2(bf2f((unsigned short)(gcur.y & 0xffffu)) * h0[2], bf2f((unsigned short)(gcur.y >> 16)) * h0[3]);
                o.z = pk2(bf2f((unsigned short)(gcur.z & 0xffffu)) * h1[0], bf2f((unsigned short)(gcur.z >> 16)) * h1[1]); o.w = pk2(bf2f((unsigned short)(gcur.w & 0xffffu)) * h1[2], bf2f((unsigned short)(gcur.w >> 16)) * h1[3]);
                *(v4u*)(Yout + (size_t)(r0 + yrow) * DR + n * 128 + yc8) = o;
                gcur = gnext;
            }
        }
        if (PASS == 1 && tid < 128) { const size_t idx = (size_t)chunk * DR + n * 128 + tid; SA[idx] = Ac; SB[idx] = h; }
        __syncthreads();
#undef LRU_LOADX
#undef LRU_STOREX
    }
}
}

enum { PH_PROLOGUE = 0, PH_NORM, PH_GU, PH_DOWN, PH_QKV, PH_ATTN, PH_WO, PH_WIN, PH_LRU1, PH_LRU2, PH_WOUT, PH_FINAL };
constexpr int NPHASES = 23;
__constant__ unsigned char PH_KIND[NPHASES] = { PH_PROLOGUE,
    PH_NORM, PH_GU, PH_DOWN,  PH_NORM, PH_QKV, PH_ATTN, PH_WO,            PH_NORM, PH_GU, PH_DOWN,
    PH_NORM, PH_GU, PH_DOWN,  PH_NORM, PH_WIN, PH_LRU1, PH_LRU2, PH_WOUT, PH_NORM, PH_GU, PH_DOWN,
    PH_FINAL };
__constant__ unsigned char PH_LAYER[NPHASES] = { 0, 0,0,0, 0,0,0,0, 0,0,0, 1,1,1, 1,1,1,1,1, 1,1,1, 1 };
__constant__ unsigned char PH_SUB[NPHASES]   = { 0, 0,0,0, 1,1,1,1, 2,2,2, 0,0,0, 1,1,1,1,1, 2,2,2, 0 };

__global__ void __launch_bounds__(NWAVES * 64, 2) fwd_kernel(Args args) {
    extern __shared__ __attribute__((aligned(16))) unsigned char lds_raw[];
    LAS unsigned char* lds = (LAS unsigned char*)lds_raw;
    volatile LAS unsigned* MISC = (volatile LAS unsigned*)(lds + MISC_OFF);
    const int tid0 = threadIdx.x;
    const int G = gridDim.x; const int bx = blockIdx.x; const int vcu = (G % 8 == 0) ? (bx % 8) * (G / 8) + bx / 8 : bx;
    unsigned char* ws0 = args.ws;
    gu32* ctl = (gu32*)(ws0 + WS_CTL);
    for (int u = tid0; u < 64; u += NWAVES * 64) MISC[u] = 0u;
    __syncthreads();
    XcdBarrier bar; bar.bar = (unsigned*)(ctl + CW_BAR); bar.x = 0; bar.st = nullptr;
    if (args.use_bar) bar = xcd_barrier_post((unsigned*)(ctl + CW_BAR), MISC + 8);

    float* X = args.out;

    for (int ph = args.ph_lo; ph < args.ph_hi; ++ph) {
        const int kind = PH_KIND[ph], l = PH_LAYER[ph], sub = PH_SUB[ph];
        const int reps = ((args.dup >> kind) & 1) ? 2 : 1;
        for (int rep = 0; rep < reps; ++rep) {
        int tid = tid0; asm volatile("" : "+v"(tid)); GAS unsigned char* wsg = (GAS unsigned char*)ws0; asm volatile("" : "+s"(wsg)); unsigned char* ws = (unsigned char*)wsg;
        const int lane = tid & 63, wave = __builtin_amdgcn_readfirstlane(tid >> 6);
        float* MOD = (float*)(ws + WS_MOD); bf16* XN = (bf16*)(ws + WS_XN);
        const float* modl = MOD + (size_t)l * BATCH * NMOD + (size_t)sub * 3 * D;
        const int fidx = l * 2 + (sub == 2 ? 1 : 0);
        const bool dry = rep + 1 < reps;
        if (kind == PH_PROLOGUE) {
            p0_prologue(args, ws, lds, vcu, G, tid, lane, wave);
        } else if (kind == PH_NORM) {
            const float* xin = (ph == 1) ? args.in[0] : X;
            norm_mod_phase(xin, args.in[4] + (size_t)(l * 3 + sub) * D, modl, modl + D, XN, vcu, G, lane, wave);
        } else if (kind == PH_GU) {
            pg8::Gemm g{XN, (const bf16*)(ws + WS_WGU) + (size_t)fidx * NGU * D, M, NGU, D}; pg8::StaticOrder S; S.init(M, NGU, G, bx);
            pg8::EpiSwiglu E{(bf16*)(ws + WS_ACT), FF};
            pg8::gemm_phase<pg8::EpiSwiglu, pg8::StaticOrder, true, true>(lds + RING_OFF, g, S, E);
        } else if (kind == PH_DOWN || kind == PH_WO || kind == PH_WOUT) {
            const bf16* A; const bf16* Bt; int K; float mw;
            if (kind == PH_DOWN) { A = (const bf16*)(ws + WS_ACT); Bt = (const bf16*)(ws + WS_WDN) + (size_t)fidx * D * FF; K = FF; mw = 0.5f; }
            else if (kind == PH_WO) { A = (const bf16*)(ws + WS_QO); Bt = (const bf16*)(ws + WS_WO); K = D; mw = 1.0f; }
            else { A = (const bf16*)(ws + WS_GG); Bt = (const bf16*)(ws + WS_WOUT); K = DR; mw = 1.0f; }
            const float* base = (ph == 3) ? args.in[0] : X;
            pg8::Gemm g{A, Bt, M, D, K}; pg8::StaticOrder S; S.init(M, D, G, bx);
            pg8::EpiResid E{base, dry ? (float*)(ws + WS_SCR) : X, D, modl + 2 * D, NMOD, mw};
            pg8::gemm_phase<pg8::EpiResid, pg8::StaticOrder, true, true>(lds + RING_OFF, g, S, E);
        } else if (kind == PH_QKV) {
            pg8::Gemm g{XN, (const bf16*)(ws + WS_WQKV), M, NQKV, D}; pg8::StaticOrder S; S.init(M, NQKV, G, bx);
            pg8::EpiQKV E{(bf16*)(ws + WS_QO), D, D, (size_t)(WS_K - WS_QO) / 2, 0.125f * LOG2E};
            pg8::gemm_phase<pg8::EpiQKV, pg8::StaticOrder, true, true>(lds + RING_OFF, g, S, E);
        } else if (kind == PH_ATTN) {
            const sba::bf16* Qp = (const sba::bf16*)(ws + WS_QO); const sba::bf16* Kp = (const sba::bf16*)(ws + WS_K); const sba::bf16* Vp = (const sba::bf16*)(ws + WS_V);
            sba::bf16* Op = (sba::bf16*)(ws + (dry ? WS_SCR : WS_QO));
            if (G == 256) {
                const int bh = vcu >> 1, hf = vcu & 1;
                for (int i = 0; i < 4; ++i) { const int qb = (i == 0) ? 7 - hf : (i == 1) ? hf : (i == 2) ? 5 - hf : 2 + hf;
                    sba::attn_unit(bh / NH, bh % NH, qb, Qp, Kp, Vp, Op, (LAS char*)(lds + RING_OFF)); }
            } else {
                for (int it = vcu; it < BATCH * NH * 8; it += G) sba::attn_unit((it >> 3) / NH, (it >> 3) % NH, it & 7, Qp, Kp, Vp, Op, (LAS char*)(lds + RING_OFF));
            }
        } else if (kind == PH_WIN) {
            pg8::Gemm g{XN, (const bf16*)(ws + WS_WIN), M, NIN, D}; pg8::StaticOrder S; S.init(M, NIN, G, bx);
            pg8::EpiLruIn E{(bf16*)(ws + WS_GG), (float*)(ws + WS_XB), DR};
            pg8::gemm_phase<pg8::EpiLruIn, pg8::StaticOrder, true, true>(lds + RING_OFF, g, S, E);
        } else if (kind == PH_LRU1) {
            { const int upw = (1280 + G - 1) / G, id0 = vcu * upw, id1 = (id0 + upw < 1280) ? id0 + upw : 1280; lru::lru_pass<1>(args, ws, nullptr, lds, id0, id1, tid, lane, wave); }
        } else if (kind == PH_LRU2) {
            { const int upw = (1280 + G - 1) / G, id0 = vcu * upw, id1 = (id0 + upw < 1280) ? id0 + upw : 1280; lru::lru_pass<2>(args, ws, (bf16*)(ws + (dry ? WS_SCR : WS_GG)), lds, id0, id1, tid, lane, wave); }
        } else {
            final_norm_phase(X, args.in[18], dry ? (float*)(ws + WS_SCR) : X, vcu, G, lane, wave);
        }
        if (dry) xcd_barrier(bar);
        }
        if (ph + 1 < args.ph_hi) xcd_barrier(bar);
    }
}

extern "C" void kernel_launch(void* const* d_in, const int* in_sizes, int n_in, void* d_out, int out_size, void* d_ws, size_t ws_size, hipStream_t stream) {
    static int grid = 0;
    if (grid == 0) {
        if (n_in != 19 || in_sizes[0] != M * D || out_size != M * D || ws_size < WS_SCR_END) { fprintf(stderr, "kernel_launch: unexpected shapes (n_in %d, in0 %d, out %d, ws %zu); nothing launched\n", n_in, n_in > 0 ? in_sizes[0] : -1, out_size, ws_size); grid = -1; return; }
        int dev = 0, cus = 0, per_cu = 0;
        if (hipGetDevice(&dev) != hipSuccess || hipDeviceGetAttribute(&cus, hipDeviceAttributeMultiprocessorCount, dev) != hipSuccess) { fprintf(stderr, "kernel_launch: device query failed\n"); grid = -1; return; }
        if (hipFuncSetAttribute((const void*)fwd_kernel, hipFuncAttributeMaxDynamicSharedMemorySize, LDS_BYTES) != hipSuccess) { fprintf(stderr, "kernel_launch: hipFuncSetAttribute failed\n"); grid = -1; return; }
        if (hipOccupancyMaxActiveBlocksPerMultiprocessor(&per_cu, (const void*)fwd_kernel, NWAVES * 64, LDS_BYTES) != hipSuccess || per_cu < 1)
            fprintf(stderr, "kernel_launch: note: occupancy query reports %d workgroups per CU\n", per_cu);
        (void)hipGetLastError();
        grid = cus;
    }
    if (grid < 0) return;
    if (hipMemsetAsync((char*)d_ws + WS_CTL, 0, CTL_ZERO_BYTES, stream) != hipSuccess) { fprintf(stderr, "kernel_launch: hipMemsetAsync failed\n"); return; }
    Args a{};
    for (int i = 0; i < 19; ++i) a.in[i] = (const float*)d_in[i];
    a.out = (float*)d_out; a.ws = (unsigned char*)d_ws; a.dup = PROBE_DUP;
#if MK_ONE_LAUNCH
    a.ph_lo = 0; a.ph_hi = NPHASES; a.use_bar = 1;
    hipLaunchKernelGGL(fwd_kernel, dim3(grid), dim3(NWAVES * 64), LDS_BYTES, stream, a);
#else
    for (int ph = 0; ph < NPHASES; ++ph) { a.ph_lo = ph; a.ph_hi = ph + 1; a.use_bar = 0;
        hipLaunchKernelGGL(fwd_kernel, dim3(grid), dim3(NWAVES * 64), LDS_BYTES, stream, a); }
#endif
    const hipError_t le = hipPeekAtLastError();
    if (le != hipSuccess) fprintf(stderr, "kernel_launch: launch failed: %s\n", hipGetErrorName(le));
}
```

```cpp
#include <hip/hip_runtime.h>
#include <hip/hip_bf16.h>
#include <cstdio>
#include <cstdint>
#include <cmath>

#ifndef PROBE_DUP
#define PROBE_DUP 0
#endif
#ifndef MK_ONE_LAUNCH
#define MK_ONE_LAUNCH 1
#endif

constexpr int BATCH = 8, SEQ = 2048, D = 1024, M = BATCH * SEQ, FF = 2816, NGU = 2 * FF, NQKV = 3 * D, DR = 1280, NIN = 2 * DR, NMOD = 9 * D, NH = 16, HD = 64;
constexpr float RMS_EPS = 1e-6f;
constexpr float LOG2E = 1.4426950408889634f;

__device__ __forceinline__ int opaque_tid() { int t = threadIdx.x; asm volatile("" : "+v"(t)); return t; }


namespace pg8 {
#define PG8_LAS __attribute__((address_space(3)))
typedef unsigned short bf16_t;
typedef short bf16x8 __attribute__((ext_vector_type(8)));
typedef float f32x4 __attribute__((ext_vector_type(4)));
typedef unsigned u32x4 __attribute__((ext_vector_type(4)));
constexpr int BM = 256, BK = 64, HALF = 128, HTB = HALF * BK * 2  , STAGE_BYTES = 8 * HTB, NXCD = 8, WGM = 8;

__host__ __device__ __forceinline__ int lds_byte(int r, int c) { const int st = (r >> 4) * 2 + (c >> 5), rr = r & 15, cc = c & 31, ob = rr * 64 + cc * 2; return st * 1024 + (ob ^ (((ob >> 9) & 1) << 5)); }
__host__ __device__ __forceinline__ void stage_rc(int b, int& R, int& C) { const int st = b / 1024, sb = b % 1024, swz = sb ^ (((sb >> 9) & 1) << 5); R = (st >> 1) * 16 + swz / 64; C = (st & 1) * 32 + (swz % 64) / 2; }
__host__ __device__ __forceinline__ int perm32(int rho) { const int n = rho >> 4, i = rho & 15; return 8 * (i >> 2) + 4 * n + (i & 3); }

struct Unit { int pm, pn; };
struct Gemm { const bf16_t* A; const bf16_t* Bt; int M, N, K; };

struct StaticOrder {
    int nM, nN, nwg, G, c;
    __host__ __device__ void init(int M, int N, int G_, int c_) { nM = M / BM; nN = N / BM; nwg = nM * nN; G = G_; c = c_; }
    __host__ __device__ bool next(int i, Unit& u) const {
        const long L = (long)i * G + c; if (L >= nwg) return false;
        int wgid = (int)L; { const int q = nwg / NXCD, r = nwg % NXCD, xcd = wgid % NXCD, off = wgid / NXCD; wgid = (xcd < r ? xcd * (q + 1) : r * (q + 1) + (xcd - r) * q) + off; }
        const int nig = WGM * nN, gid = wgid / nig, fm = gid * WGM, gsz = (nM - fm) < WGM ? (nM - fm) : WGM;
        u.pm = fm + ((wgid % nig) % gsz); u.pn = (wgid % nig) / gsz; return true;
    }
    __device__ __forceinline__ void a_ready(const Unit&) const {}
    __device__ __forceinline__ void done(const Unit&) const {}
};

__device__ __forceinline__ unsigned cvt_pk_bf16(float lo, float hi) { unsigned r; asm volatile("v_cvt_pk_bf16_f32 %0, %1, %2" : "=v"(r) : "v"(lo), "v"(hi)); return r; }
typedef unsigned u32x2 __attribute__((ext_vector_type(2)));

struct EpiQKV {
    static constexpr bool PERM = true, AFTER_DRAIN = false;
    bf16_t* O; int ldc; int split_cols; size_t split_stride; float scale0;
    __device__ __forceinline__ void operator()(const f32x4 (&acc)[2][2][4][2], const Unit& u, int wr, int wc, int fr, int fq) const {
        const int row0 = u.pm * BM + wr * 64 + fr; int colt = u.pn * BM; bf16_t* base = O;
        float sc = 1.f; { const int t = colt / split_cols; base += (size_t)t * split_stride; colt -= t * split_cols; if (t == 0) sc = scale0; }
        const int col0 = colt + wc * 32 + 8 * fq;
#pragma unroll
        for (int ai = 0; ai < 2; ++ai)
#pragma unroll
            for (int m = 0; m < 4; ++m) { bf16_t* rowp = base + (size_t)(row0 + ai * HALF + m * 16) * ldc + col0;
#pragma unroll
                for (int bj = 0; bj < 2; ++bj) { f32x4 v0 = acc[ai][bj][m][0] * sc, v1 = acc[ai][bj][m][1] * sc;
                    u32x4 w; w.x = cvt_pk_bf16(v0[0], v0[1]); w.y = cvt_pk_bf16(v0[2], v0[3]); w.z = cvt_pk_bf16(v1[0], v1[1]); w.w = cvt_pk_bf16(v1[2], v1[3]);
                    *(u32x4*)(rowp + bj * HALF) = w; } }
    }
};

__device__ __forceinline__ float silu_mul(float g, float u) { return g * __builtin_amdgcn_rcpf(1.0f + __builtin_amdgcn_exp2f(-g * 1.4426950408889634f)) * u; }
struct EpiSwiglu {
    static constexpr bool PERM = true, AFTER_DRAIN = false;
    bf16_t* O; int ldc;
    __device__ __forceinline__ void operator()(const f32x4 (&acc)[2][2][4][2], const Unit& u, int wr, int wc, int fr, int fq) const {
        const int row0 = u.pm * BM + wr * 64 + fr, col0 = u.pn * HALF + wc * 32 + 8 * fq;
#pragma unroll
        for (int ai = 0; ai < 2; ++ai)
#pragma unroll
            for (int m = 0; m < 4; ++m) { bf16_t* rowp = O + (size_t)(row0 + ai * HALF + m * 16) * ldc + col0;
                const f32x4 g0 = acc[ai][0][m][0], g1 = acc[ai][0][m][1], u0 = acc[ai][1][m][0], u1 = acc[ai][1][m][1];
                u32x4 w;
                w.x = cvt_pk_bf16(silu_mul(g0[0], u0[0]), silu_mul(g0[1], u0[1])); w.y = cvt_pk_bf16(silu_mul(g0[2], u0[2]), silu_mul(g0[3], u0[3]));
                w.z = cvt_pk_bf16(silu_mul(g1[0], u1[0]), silu_mul(g1[1], u1[1])); w.w = cvt_pk_bf16(silu_mul(g1[2], u1[2]), silu_mul(g1[3], u1[3]));
                *(u32x4*)rowp = w; }
    }
};

struct EpiResid {
    static constexpr bool PERM = false, AFTER_DRAIN = false;
    const float* base; float* out; int ldc; const float* gate; int gstride; float mw;
    __device__ __forceinline__ void operator()(const f32x4 (&acc)[2][2][4][2], const Unit& u, int wr, int wc, int fr, int fq) const {
        const int row0 = u.pm * BM + wr * 64 + fr, col0 = u.pn * BM + wc * 32 + 4 * fq;
        const float* gp = gate + (size_t)(u.pm >> 3) * gstride + col0;
        f32x4 gv[2][2];
#pragma unroll
        for (int bj = 0; bj < 2; ++bj)
#pragma unroll
            for (int n = 0; n < 2; ++n) gv[bj][n] = (*(const f32x4*)(gp + bj * HALF + n * 16) + 1.0f) * mw;
#pragma unroll
        for (int ai = 0; ai < 2; ++ai)
#pragma unroll
            for (int m = 0; m < 4; ++m) { const size_t off = (size_t)(row0 + ai * HALF + m * 16) * ldc + col0;
#pragma unroll
                for (int bj = 0; bj < 2; ++bj)
#pragma unroll
                    for (int n = 0; n < 2; ++n) { const f32x4 bs = *(const f32x4*)(base + off + bj * HALF + n * 16); *(f32x4*)(out + off + bj * HALF + n * 16) = bs + gv[bj][n] * acc[ai][bj][m][n]; } }
    }
};

__device__ __forceinline__ float gelu_tanh(float x) { const float y = x * (1.5957691216057308f + 0.0713548162726f * x * x); return x * __builtin_amdgcn_rcpf(1.0f + __builtin_amdgcn_exp2f(-y * 1.4426950408889634f)); }
struct EpiLruIn {
    static constexpr bool PERM = false, AFTER_DRAIN = false;
    bf16_t* GG; float* XB; int ldc;
    __device__ __forceinline__ void operator()(const f32x4 (&acc)[2][2][4][2], const Unit& u, int wr, int wc, int fr, int fq) const {
        const int row0 = u.pm * BM + wr * 64 + fr;
        if (u.pn < 5) {
            const int col0 = u.pn * BM + wc * 32 + 4 * fq;
#pragma unroll
            for (int ai = 0; ai < 2; ++ai)
#pragma unroll
                for (int m = 0; m < 4; ++m) { bf16_t* rowp = GG + (size_t)(row0 + ai * HALF + m * 16) * ldc + col0;
#pragma unroll
                    for (int bj = 0; bj < 2; ++bj)
#pragma unroll
                        for (int n = 0; n < 2; ++n) { const f32x4 v = acc[ai][bj][m][n]; u32x2 w; w.x = cvt_pk_bf16(gelu_tanh(v[0]), gelu_tanh(v[1])); w.y = cvt_pk_bf16(gelu_tanh(v[2]), gelu_tanh(v[3]));
                            *(u32x2*)(rowp + bj * HALF + n * 16) = w; } }
        } else {
            const int col0 = (u.pn - 5) * BM + wc * 32 + 4 * fq;
#pragma unroll
            for (int ai = 0; ai < 2; ++ai)
#pragma unroll
                for (int m = 0; m < 4; ++m) { float* rowp = XB + (size_t)(row0 + ai * HALF + m * 16) * ldc + col0;
#pragma unroll
                    for (int bj = 0; bj < 2; ++bj)
#pragma unroll
                        for (int n = 0; n < 2; ++n) *(f32x4*)(rowp + bj * HALF + n * 16) = acc[ai][bj][m][n]; }
        }
    }
};

template <class Epi, class Sched, bool ALIGN_EPI = false, bool SP2 = false>
__device__ __forceinline__ void gemm_phase(PG8_LAS unsigned char* lds, const Gemm g, const Sched& S, const Epi& E) {
    const int tid = opaque_tid(), wid = __builtin_amdgcn_readfirstlane(tid >> 6), lane = tid & 63, wr = wid >> 2, wc = wid & 3, fr = lane & 15, fq = lane >> 4;
    const int K = g.K, nt = K / BK;
    unsigned voffA[2], voffB[2];
#pragma unroll
    for (int i = 0; i < 2; ++i) { int R, C; stage_rc(tid * 16 + i * 8192, R, C); const int Rb = Epi::PERM ? ((R & ~31) + perm32(R & 31)) : R;
        voffA[i] = (unsigned)(R * K + C) * 2u; voffB[i] = (unsigned)(Rb * K + C) * 2u; }
    const size_t kstep = (size_t)(BK * 2);
    const size_t hstep = (size_t)HALF * K * 2;
    const size_t tstep = 2 * hstep;
    const unsigned ldsw = (unsigned)wid * 1024u;
    const int aoff = lds_byte(wr * 64 + fr, fq * 8), boff = lds_byte(wc * 32 + fr, fq * 8);
#define PG8_SA(b, h) (((b) * 2 + (h)) * HTB)
#define PG8_SB(b, h) ((4 + (b) * 2 + (h)) * HTB)
#define PG8_STAGE(bufoff, gbase, voff) do { _Pragma("unroll") for (int _i = 0; _i < 2; ++_i) \
        __builtin_amdgcn_global_load_lds((const unsigned*)((const char*)(gbase) + (voff)[_i]), (PG8_LAS unsigned*)(lds + (bufoff) + ldsw + _i * 8192), 16, 0, 0); } while (0)
#define PG8_LDA(dst, b, h) do { _Pragma("unroll") for (int m = 0; m < 4; ++m) _Pragma("unroll") for (int k = 0; k < 2; ++k) dst[m][k] = *(const PG8_LAS bf16x8*)(lds + PG8_SA(b, h) + aoff + m * 2048 + k * 1024); } while (0)
#define PG8_LDB(dst, b, h) do { _Pragma("unroll") for (int n = 0; n < 2; ++n) _Pragma("unroll") for (int k = 0; k < 2; ++k) dst[n][k] = *(const PG8_LAS bf16x8*)(lds + PG8_SB(b, h) + boff + n * 2048 + k * 1024); } while (0)
#define PG8_MMA(ai, bj, At, Bt) do { __builtin_amdgcn_s_setprio(1); _Pragma("unroll") for (int m = 0; m < 4; ++m) _Pragma("unroll") for (int n = 0; n < 2; ++n) _Pragma("unroll") for (int k = 0; k < 2; ++k) \
        acc[ai][bj][m][n] = __builtin_amdgcn_mfma_f32_16x16x32_bf16(Bt[n][k], At[m][k], acc[ai][bj][m][n], 0, 0, 0); __builtin_amdgcn_s_setprio(0); } while (0)
#define PG8_WAIT_V(n) asm volatile("s_waitcnt vmcnt(" #n ")" ::: "memory")
#define PG8_WAIT_L(n) asm volatile("s_waitcnt lgkmcnt(" #n ")" ::: "memory")
#define PG8_BAR __builtin_amdgcn_s_barrier()
#define PG8_SCHED __builtin_amdgcn_sched_barrier(0)
    Unit cur, nxt; int ui = 0;
    if (!S.next(0, cur)) return;
    f32x4 acc[2][2][4][2];
#pragma unroll
    for (int a = 0; a < 2; ++a)
#pragma unroll
        for (int b = 0; b < 2; ++b)
#pragma unroll
            for (int m = 0; m < 4; ++m)
#pragma unroll
                for (int n = 0; n < 2; ++n) acc[a][b][m][n] = (f32x4){0.f, 0.f, 0.f, 0.f};
    bf16x8 At[4][2], B0[2][2], B1[2][2];
    const char* cA = (const char*)g.A + (size_t)cur.pm * tstep; const char* cB = (const char*)g.Bt + (size_t)cur.pn * tstep;
    S.a_ready(cur);
    if constexpr (SP2) {
        PG8_STAGE(PG8_SB(0, 0), cB, voffB); PG8_STAGE(PG8_SB(0, 1), cB + hstep, voffB); PG8_STAGE(PG8_SA(0, 0), cA, voffA); PG8_STAGE(PG8_SA(0, 1), cA + hstep, voffA);
        if (wr == 1) PG8_BAR;
        PG8_WAIT_V(2); PG8_BAR;
        PG8_STAGE(PG8_SB(1, 0), cB + kstep, voffB); PG8_STAGE(PG8_SA(1, 0), cA + kstep, voffA); PG8_STAGE(PG8_SB(1, 1), cB + hstep + kstep, voffB);
        PG8_WAIT_V(6); PG8_BAR;
    } else {
        PG8_STAGE(PG8_SB(0, 0), cB, voffB); PG8_STAGE(PG8_SA(0, 0), cA, voffA); PG8_STAGE(PG8_SB(0, 1), cB + hstep, voffB); PG8_STAGE(PG8_SA(0, 1), cA + hstep, voffA);
        if (wr == 1) PG8_BAR;
        PG8_WAIT_V(4); PG8_BAR;
        PG8_STAGE(PG8_SB(1, 0), cB + kstep, voffB); PG8_STAGE(PG8_SA(1, 0), cA + kstep, voffA); PG8_STAGE(PG8_SB(1, 1), cB + hstep + kstep, voffB);
        PG8_WAIT_V(6); PG8_BAR;
    }
    for (;;) {
        const bool has_next = S.next(ui + 1, nxt);
        const char* nA = has_next ? (const char*)g.A + (size_t)nxt.pm * tstep : cA; const char* nB = has_next ? (const char*)g.Bt + (size_t)nxt.pn * tstep : cB;
        for (int t = 0; t < nt; t += 2) {
            const bool last = (t == nt - 2);
            const char* a1 = cA + (size_t)(t + 1) * kstep;
            const char* a2 = last ? nA : cA + (size_t)(t + 2) * kstep; const char* b2 = last ? nB : cB + (size_t)(t + 2) * kstep;
            const char* a3 = a2 + kstep; const char* b3 = b2 + kstep;
            if (last && has_next) S.a_ready(nxt);
            if constexpr (SP2) {
            PG8_LDB(B0, 0, 0); PG8_LDB(B1, 0, 1); PG8_SCHED; PG8_LDA(At, 0, 0); PG8_STAGE(PG8_SA(1, 1), a1 + hstep, voffA);
            PG8_WAIT_V(8); PG8_WAIT_L(0); PG8_BAR; PG8_MMA(0, 0, At, B0); PG8_MMA(0, 1, At, B1); PG8_BAR; PG8_SCHED;
            PG8_LDA(At, 0, 1); PG8_STAGE(PG8_SB(0, 0), b2, voffB); PG8_STAGE(PG8_SB(0, 1), b2 + hstep, voffB); PG8_STAGE(PG8_SA(0, 0), a2, voffA);
            PG8_WAIT_V(8); PG8_WAIT_L(0); PG8_BAR; PG8_MMA(1, 0, At, B0); PG8_MMA(1, 1, At, B1); PG8_BAR; PG8_SCHED;
            PG8_LDB(B0, 1, 0); PG8_LDB(B1, 1, 1); PG8_SCHED; PG8_LDA(At, 1, 0); PG8_STAGE(PG8_SA(0, 1), a2 + hstep, voffA);
            PG8_WAIT_V(8); PG8_WAIT_L(0); PG8_BAR; PG8_MMA(0, 0, At, B0); PG8_MMA(0, 1, At, B1); PG8_BAR; PG8_SCHED;
            PG8_LDA(At, 1, 1); PG8_STAGE(PG8_SB(1, 0), b3, voffB); PG8_STAGE(PG8_SB(1, 1), b3 + hstep, voffB); PG8_STAGE(PG8_SA(1, 0), a3, voffA);
            PG8_WAIT_V(8); PG8_WAIT_L(0); PG8_BAR; PG8_MMA(1, 0, At, B0); PG8_MMA(1, 1, At, B1); PG8_BAR; PG8_SCHED;
            } else {
            PG8_LDB(B0, 0, 0); PG8_SCHED; PG8_LDA(At, 0, 0); PG8_STAGE(PG8_SA(1, 1), a1 + hstep, voffA);
            PG8_WAIT_L(8); PG8_BAR; PG8_WAIT_L(0); PG8_MMA(0, 0, At, B0); PG8_BAR; PG8_SCHED;
            PG8_LDB(B1, 0, 1); PG8_STAGE(PG8_SB(0, 0), b2, voffB);
            PG8_BAR; PG8_WAIT_L(0); PG8_MMA(0, 1, At, B1); PG8_BAR;
            PG8_LDA(At, 0, 1); PG8_STAGE(PG8_SA(0, 0), a2, voffA);
            PG8_BAR; PG8_WAIT_L(0); PG8_MMA(1, 0, At, B0); PG8_BAR; PG8_SCHED;
            PG8_STAGE(PG8_SB(0, 1), b2 + hstep, voffB);
            PG8_WAIT_V(6); PG8_BAR; PG8_MMA(1, 1, At, B1); PG8_BAR;
            PG8_LDB(B0, 1, 0); PG8_SCHED; PG8_LDA(At, 1, 0); PG8_STAGE(PG8_SA(0, 1), a2 + hstep, voffA);
            PG8_WAIT_L(8); PG8_BAR; PG8_WAIT_L(0); PG8_MMA(0, 0, At, B0); PG8_BAR; PG8_SCHED;
            PG8_LDB(B1, 1, 1); PG8_STAGE(PG8_SB(1, 0), b3, voffB);
            PG8_BAR; PG8_WAIT_L(0); PG8_MMA(0, 1, At, B1); PG8_BAR;
            PG8_LDA(At, 1, 1); PG8_STAGE(PG8_SA(1, 0), a3, voffA);
            PG8_BAR; PG8_WAIT_L(0); PG8_MMA(1, 0, At, B0); PG8_BAR; PG8_SCHED;
            PG8_STAGE(PG8_SB(1, 1), b3 + hstep, voffB);
            PG8_WAIT_V(6); PG8_BAR; PG8_MMA(1, 1, At, B1); PG8_BAR;
            }
        }
        if constexpr (ALIGN_EPI) { if (wr == 0) PG8_BAR; }
        if constexpr (!Epi::AFTER_DRAIN) { E(acc, cur, wr, wc, fr, fq); S.done(cur); }
        if (!has_next) break;
#pragma unroll
        for (int a = 0; a < 2; ++a)
#pragma unroll
            for (int b = 0; b < 2; ++b)
#pragma unroll
                for (int m = 0; m < 4; ++m)
#pragma unroll
                    for (int n = 0; n < 2; ++n) acc[a][b][m][n] = (f32x4){0.f, 0.f, 0.f, 0.f};
        cur = nxt; cA = nA; cB = nB; ++ui;
        if constexpr (ALIGN_EPI) { if (wr == 1) PG8_BAR; }
    }
    PG8_WAIT_V(0);
    if constexpr (!ALIGN_EPI) { if (wr == 0) PG8_BAR; }
    PG8_BAR;
    if constexpr (Epi::AFTER_DRAIN) { E.fused(acc, cur, wr, wc, fr, fq, lds, wid, lane); S.done(cur); }
#undef PG8_SA
#undef PG8_SB
#undef PG8_STAGE
#undef PG8_LDA
#undef PG8_LDB
#undef PG8_MMA
#undef PG8_WAIT_V
#undef PG8_WAIT_L
#undef PG8_BAR
#undef PG8_SCHED
}
}
namespace sba {
using bf16x8 = __attribute__((ext_vector_type(8))) short;
using s16x4 = __attribute__((ext_vector_type(4))) short;
using f32x16 = __attribute__((ext_vector_type(16))) float;
using u32x4 = __attribute__((ext_vector_type(4))) unsigned;
typedef unsigned short bf16;
constexpr int DM = 1024, KVBLK = 64, QBLK = 32, QB = 256, SLOTB = 8192;
constexpr int LDS_K = 0, LDS_V = 2 * SLOTB, LDS_OST = 4 * SLOTB, LDS_BYTES = LDS_OST + 8 * 4096;
__device__ __forceinline__ int crow(int r, int hi) { return (r & 3) + 8 * (r >> 2) + 4 * hi; }
__device__ __forceinline__ void glds16(const void* gsrc, unsigned lds_dst) { unsigned keep;
    asm volatile("s_mov_b32 %0, m0\n\ts_mov_b32 m0, %2\n\ts_nop 0\n\tglobal_load_lds_dwordx4 %1, off\n\ts_mov_b32 m0, %0" : "=&s"(keep) : "v"(gsrc), "s"(lds_dst) : "memory"); }
typedef float f32x2_t __attribute__((ext_vector_type(2))); typedef __bf16 bf16x2_t __attribute__((ext_vector_type(2)));
__device__ __forceinline__ unsigned cvtpk_s(float lo, float hi) { f32x2_t v = {lo, hi}; bf16x2_t b = __builtin_convertvector(v, bf16x2_t); return __builtin_bit_cast(unsigned, b); }
#define SBA_WAIT_BAR() asm volatile("s_waitcnt vmcnt(0) lgkmcnt(0)\n\ts_barrier" ::: "memory")
typedef __attribute__((address_space(3))) const char* lds_cptr;

__device__ __forceinline__ void qkt(f32x16& p0, f32x16& p1, lds_cptr Kslot, const bf16x8* qr, int r32, int hi) {
    lds_cptr kb = Kslot + hi * 1024 + r32 * 16;
    const f32x16 z = f32x16{};
#pragma unroll
    for (int d0 = 0; d0 < 4; ++d0) {
        const bf16x8 b0 = *(const __attribute__((address_space(3))) bf16x8*)(kb + d0 * 2048);
        const bf16x8 b1 = *(const __attribute__((address_space(3))) bf16x8*)(kb + d0 * 2048 + 512);
        if (d0 == 0) { p0 = __builtin_amdgcn_mfma_f32_32x32x16_bf16(b0, qr[0], z, 0, 0, 0); p1 = __builtin_amdgcn_mfma_f32_32x32x16_bf16(b1, qr[0], z, 0, 0, 0); }
        else { p0 = __builtin_amdgcn_mfma_f32_32x32x16_bf16(b0, qr[d0], p0, 0, 0, 0); p1 = __builtin_amdgcn_mfma_f32_32x32x16_bf16(b1, qr[d0], p1, 0, 0, 0); } }
}
__device__ __forceinline__ void pv(f32x16* o, int vb, bf16x8 pa0, bf16x8 pa1, bf16x8 pa2, bf16x8 pa3) {
#pragma unroll
    for (int d0 = 0; d0 < 2; ++d0) { s16x4 lo[4], hi[4];
#pragma unroll
        for (int ks = 0; ks < 4; ++ks) {
            asm volatile("ds_read_b64_tr_b16 %0,%1 offset:%c2" : "=&v"(lo[ks]) : "v"(vb), "i"(d0 * 4096 + ks * 1024) : "memory");
            asm volatile("ds_read_b64_tr_b16 %0,%1 offset:%c2" : "=&v"(hi[ks]) : "v"(vb), "i"(d0 * 4096 + ks * 1024 + 512) : "memory"); }
        asm volatile("s_waitcnt lgkmcnt(0)" ::: "memory"); __builtin_amdgcn_sched_barrier(0);
#define SBA_PK(k) (bf16x8){lo[k][0], lo[k][1], lo[k][2], lo[k][3], hi[k][0], hi[k][1], hi[k][2], hi[k][3]}
        o[d0] = __builtin_amdgcn_mfma_f32_32x32x16_bf16(pa0, SBA_PK(0), o[d0], 0, 0, 0);
        o[d0] = __builtin_amdgcn_mfma_f32_32x32x16_bf16(pa1, SBA_PK(1), o[d0], 0, 0, 0);
        o[d0] = __builtin_amdgcn_mfma_f32_32x32x16_bf16(pa2, SBA_PK(2), o[d0], 0, 0, 0);
        o[d0] = __builtin_amdgcn_mfma_f32_32x32x16_bf16(pa3, SBA_PK(3), o[d0], 0, 0, 0);
#undef SBA_PK
    }
}

__device__ __forceinline__ void sb_weights(f32x16& p0, f32x16& p1, float& carry, int hi, int qk, bool diag) {
    f32x16 k0v, k1v;
#pragma unroll
    for (int r = 0; r < 16; ++r) {
        const float e0 = __builtin_amdgcn_exp2f(__builtin_fminf(p0[r], 64.f)), e1 = __builtin_amdgcn_exp2f(__builtin_fminf(p1[r], 64.f));
        float kp0 = __builtin_amdgcn_rcpf(1.0f + e0), kp1 = __builtin_amdgcn_rcpf(1.0f + e1);
        float sg0 = e0 * kp0, sg1 = e1 * kp1;
        if (diag) { const int kk = crow(r, hi); if (kk >= qk) { kp0 = 1.f; sg0 = 0.f; } if (kk + 32 >= qk) { kp1 = 1.f; sg1 = 0.f; } }
        k0v[r] = kp0; k1v[r] = kp1; p0[r] = sg0; p1[r] = sg1;
    }
    float R = carry;
#define SBA_GROUP(P, KV, g) do { \
        const float q2 = KV[4 * (g) + 3], q1 = q2 * KV[4 * (g) + 2], q0 = q1 * KV[4 * (g) + 1], gp = q0 * KV[4 * (g)]; \
        const unsigned own = __float_as_uint(gp); auto rr = __builtin_amdgcn_permlane32_swap(own, own, false, false); \
        const float other = __uint_as_float(rr[0] ^ rr[1] ^ own), pairp = __uint_as_float(rr[0]) * __uint_as_float(rr[1]); \
        const float rin = hi ? R : R * other; \
        P[4 * (g) + 3] *= rin; P[4 * (g) + 2] *= rin * q2; P[4 * (g) + 1] *= rin * q1; P[4 * (g)] *= rin * q0; \
        R *= pairp; } while (0)
    SBA_GROUP(p1, k1v, 3); SBA_GROUP(p1, k1v, 2); SBA_GROUP(p1, k1v, 1); SBA_GROUP(p1, k1v, 0);
    SBA_GROUP(p0, k0v, 3); SBA_GROUP(p0, k0v, 2); SBA_GROUP(p0, k0v, 1); SBA_GROUP(p0, k0v, 0);
#undef SBA_GROUP
    carry = R;
}

__device__ __forceinline__ void attn_unit(int b, int h, int qb, const bf16* Q, const bf16* K, const bf16* V, bf16* O, __attribute__((address_space(3))) char* shm) {
    const int tid = opaque_tid(), lane = tid & 63, r32 = lane & 31, hi = lane >> 5; const int wid = __builtin_amdgcn_readfirstlane(tid >> 6);
    const long rowbase = (long)b * SEQ; const int q0 = qb * QB;
    const bf16* Qw = Q + (rowbase + q0 + wid * QBLK) * DM + h * HD;
    const bf16* Kh = K + rowbase * DM + h * HD, * Vh = V + rowbase * DM + h * HD;
    const unsigned lds0 = (unsigned)(uintptr_t)shm;
    const bf16* ksrc = Kh + (long)lane * DM + wid * 8;
    const bf16* vsrc = Vh + (long)(16 * (wid & 3) + (lane >> 2)) * DM + (wid >> 2) * 32 + (lane & 3) * 8;
    const unsigned kdst = lds0 + LDS_K + wid * 1024, vdst = lds0 + LDS_V + wid * 1024;
#define SBA_DMA_K(t, slot) glds16(ksrc + (long)(t) * KVBLK * DM, (unsigned)__builtin_amdgcn_readfirstlane(kdst + (slot)))
#define SBA_DMA_V(t, slot) glds16(vsrc + (long)(t) * KVBLK * DM, (unsigned)__builtin_amdgcn_readfirstlane(vdst + (slot)))
    const int vb0 = (int)(lds0 + LDS_V) + ((lane >> 4) & 1) * 32 + (lane & 3) * 8 + (4 * hi + ((lane & 15) >> 2)) * 64;
    const lds_cptr shm3 = (lds_cptr)shm;
    const int NT = (q0 + QB) / KVBLK;
    SBA_DMA_K(NT - 1, 0); SBA_DMA_V(NT - 1, 0);
    bf16x8 qr[4];
#pragma unroll
    for (int d0 = 0; d0 < 4; ++d0) qr[d0] = *reinterpret_cast<const bf16x8*>(&Qw[(long)r32 * DM + d0 * 16 + hi * 8]);
    f32x16 o[2]; o[0] = f32x16{}; o[1] = f32x16{};
    float carry = 1.0f;
    const int qw0 = q0 + wid * QBLK;
    int slot = 0;
    for (int t = NT - 1; t >= 0; --t) {
        SBA_WAIT_BAR();
        if (t > 0) { SBA_DMA_K(t - 1, slot ^ SLOTB); SBA_DMA_V(t - 1, slot ^ SLOTB); }
        if (64 * t <= qw0) {
            f32x16 p0, p1;
            qkt(p0, p1, shm3 + LDS_K + slot, qr, r32, hi);
            sb_weights(p0, p1, carry, hi, qw0 + r32 - 64 * t, 64 * t + 64 > qw0);
            u32x4 pw0, pw1, pw2, pw3;
            pw0 = (u32x4){cvtpk_s(p0[0], p0[1]), cvtpk_s(p0[2], p0[3]), cvtpk_s(p0[4], p0[5]), cvtpk_s(p0[6], p0[7])};
            pw1 = (u32x4){cvtpk_s(p0[8], p0[9]), cvtpk_s(p0[10], p0[11]), cvtpk_s(p0[12], p0[13]), cvtpk_s(p0[14], p0[15])};
            pw2 = (u32x4){cvtpk_s(p1[0], p1[1]), cvtpk_s(p1[2], p1[3]), cvtpk_s(p1[4], p1[5]), cvtpk_s(p1[6], p1[7])};
            pw3 = (u32x4){cvtpk_s(p1[8], p1[9]), cvtpk_s(p1[10], p1[11]), cvtpk_s(p1[12], p1[13]), cvtpk_s(p1[14], p1[15])};
            __builtin_amdgcn_sched_barrier(0);
            pv(o, vb0 + slot, __builtin_bit_cast(bf16x8, pw0), __builtin_bit_cast(bf16x8, pw1), __builtin_bit_cast(bf16x8, pw2), __builtin_bit_cast(bf16x8, pw3));
        }
        slot ^= SLOTB;
    }
    bf16* Ow = O + (rowbase + q0 + wid * QBLK) * DM + h * HD;
    { __attribute__((address_space(3))) bf16* stg = (__attribute__((address_space(3))) bf16*)(shm3 + LDS_OST) + wid * 2048;
#pragma unroll
      for (int r = 0; r < 16; ++r) { const int orow = crow(r, hi);
#pragma unroll
        for (int d0 = 0; d0 < 2; ++d0) { const unsigned pk = cvtpk_s(o[d0][r], 0.f); stg[orow * 64 + d0 * 32 + r32] = (bf16)(pk & 0xffffu); } }
      asm volatile("s_waitcnt lgkmcnt(0)" ::: "memory");
#pragma unroll
      for (int i = 0; i < 4; ++i) { const int row = i * 8 + (lane >> 3), ch = lane & 7; const u32x4 v = *(const __attribute__((address_space(3))) u32x4*)(stg + row * 64 + ch * 8); *(u32x4*)(Ow + (long)row * DM + ch * 8) = v; } }
    asm volatile("s_waitcnt lgkmcnt(0)\n\ts_barrier" ::: "memory");
#undef SBA_DMA_K
#undef SBA_DMA_V
}
#undef SBA_WAIT_BAR
}

#define GAS __attribute__((address_space(1)))
#define LAS __attribute__((address_space(3)))
typedef unsigned short bf16;
typedef unsigned v4u __attribute__((ext_vector_type(4)));
typedef unsigned v2u __attribute__((ext_vector_type(2)));
typedef float f32x4 __attribute__((ext_vector_type(4)));
typedef short bf16x8 __attribute__((ext_vector_type(8)));
typedef GAS unsigned gu32;
#define RLX_AGENT __ATOMIC_RELAXED, __HIP_MEMORY_SCOPE_AGENT
#define LDS_WAIT() asm volatile("s_waitcnt lgkmcnt(0)" ::: "memory")
#define VM_WAIT() asm volatile("s_waitcnt vmcnt(0)" ::: "memory")
constexpr int NWAVES = 8;

constexpr size_t MiB = 1u << 20;
constexpr size_t WS_CTL = 0, CTL_ZERO_BYTES = 1 * MiB;
constexpr size_t WS_MOD = 1 * MiB;
constexpr size_t WS_SA = 2 * MiB, WS_SB = 3 * MiB;
constexpr size_t WS_WGU = 4 * MiB;
constexpr size_t WS_WDN = 48 * MiB;
constexpr size_t WS_WQKV = 70 * MiB, WS_WO = 76 * MiB, WS_WIN = 78 * MiB, WS_WOUT = 83 * MiB, WS_WRI = 86 * MiB;
constexpr size_t WS_XN = 88 * MiB;
constexpr size_t WS_OV = 120 * MiB;
constexpr size_t WS_ACT = WS_OV, WS_QO = WS_OV, WS_K = WS_OV + 32 * MiB, WS_V = WS_OV + 64 * MiB, WS_GG = WS_OV, WS_XB = WS_OV + 40 * MiB;
constexpr size_t WS_END = 240 * MiB;
constexpr size_t WS_SCR = 256 * MiB, WS_SCR_END = 320 * MiB;
static_assert(WS_WGU + 4 * (size_t)NGU * D * 2 <= WS_WDN && WS_WDN + 4 * (size_t)D * FF * 2 <= WS_WQKV && WS_WQKV + (size_t)NQKV * D * 2 <= WS_WO && WS_WO + (size_t)D * D * 2 <= WS_WIN &&
              WS_WIN + (size_t)NIN * D * 2 <= WS_WOUT && WS_WOUT + (size_t)D * DR * 2 <= WS_WRI && WS_WRI + 10 * 256 * 128 * 2 <= WS_XN && WS_XN + (size_t)M * D * 2 <= WS_OV &&
              WS_ACT + (size_t)M * FF * 2 <= WS_END && WS_V + (size_t)M * D * 2 <= WS_END && WS_XB + (size_t)M * DR * 4 <= WS_END && WS_GG + (size_t)M * DR * 2 <= WS_XB, "d_ws map");
constexpr int CW_BAR = 4096;

constexpr int RING_OFF = 0, RING_BYTES = 131072;
constexpr int LDS_BYTES = 155648;
constexpr int MISC_OFF = LDS_BYTES - 256;

__device__ __forceinline__ unsigned f2bf(float f) { unsigned u = __builtin_bit_cast(unsigned, f); return (u + 0x7fffu + ((u >> 16) & 1u)) >> 16; }
__device__ __forceinline__ unsigned pk2(float lo, float hi) { return f2bf(lo) | (f2bf(hi) << 16); }
__device__ __forceinline__ float bf2f(unsigned short b) { return __builtin_bit_cast(float, (unsigned)b << 16); }

#define XB_TMO      128
#define XB_XCNT(j)  (256  + 64 * (j))
#define XB_XSUB(j)  (1280 + 64 * (j))
#define XB_XGEN(j)  (2304 + 64 * (j))
#define XB_TOP      3328
#define XB_TOPGEN   3392
#define XCD_BAR_WORDS 3456
#define XB_SPIN_CAP (1u << 18)
__device__ __forceinline__ unsigned xb_ld(unsigned* p)              { return __hip_atomic_load(p, __ATOMIC_RELAXED, __HIP_MEMORY_SCOPE_AGENT); }
__device__ __forceinline__ unsigned xb_add(unsigned* p, unsigned v) { return __hip_atomic_fetch_add(p, v, __ATOMIC_RELAXED, __HIP_MEMORY_SCOPE_AGENT); }
__device__ __forceinline__ unsigned xb_xcc_id() { return (unsigned)__builtin_amdgcn_s_getreg((3 << 11) | 20) & 0xFu; }
#define XB_SPIN(cond, bar) do { unsigned _sp = 0; while (cond) { __builtin_amdgcn_s_sleep(1); \
    if ((++_sp & 255u) == 0u) { if (xb_ld(&(bar)[XB_TMO])) break; if (_sp > XB_SPIN_CAP) { atomicAdd(&(bar)[XB_TMO], 1u); break; } } } } while (0)
struct XcdBarrier { unsigned* bar; unsigned x; volatile LAS unsigned* st; };
__device__ __forceinline__ XcdBarrier xcd_barrier_post(unsigned* bar, volatile LAS unsigned* st) {
    XcdBarrier b; b.bar = bar; b.x = xb_xcc_id(); b.st = st;
    if (threadIdx.x == 0) (void)xb_add(&bar[XB_XCNT(b.x)], 1u);
    return b;
}
__device__ __forceinline__ void xcd_barrier_complete(unsigned* bar, unsigned x, unsigned& nloc, unsigned& nx) {
    const unsigned G = gridDim.x * gridDim.y * gridDim.z;
    unsigned sum, cnt, mine, sp = 0u;
    for (;;) {
        sum = 0u; cnt = 0u; mine = 0u;
#pragma unroll
        for (unsigned j = 0; j < 16; ++j) { const unsigned c = xb_ld(&bar[XB_XCNT(j)]); sum += c; cnt += (c > 0u) ? 1u : 0u; mine = (j == x) ? c : mine; }
        if (sum == G) break;
        __builtin_amdgcn_s_sleep(1);
        if ((++sp & 255u) == 0u) { if (xb_ld(&bar[XB_TMO])) break; if (sp > XB_SPIN_CAP) { atomicAdd(&bar[XB_TMO], 1u); break; } }
    }
    nloc = mine > 0u ? mine : 1u; nx = cnt > 0u ? cnt : 1u;
}
__device__ __forceinline__ void xcd_barrier(const XcdBarrier& b) {
    asm volatile("s_waitcnt vmcnt(0)" ::: "memory");
    __syncthreads();
    if (threadIdx.x == 0) {
        GAS unsigned* barg = (GAS unsigned*)b.bar; asm volatile("" : "+s"(barg)); unsigned* bar = (unsigned*)barg;
        __builtin_amdgcn_s_waitcnt(0);
        unsigned nloc = b.st[0], nx = b.st[1];
        if (nloc == 0u) { xcd_barrier_complete(bar, b.x, nloc, nx); b.st[0] = nloc; b.st[1] = nx; }
        const unsigned old = xb_add(&bar[XB_XSUB(b.x)], 1u);
        const unsigned gen = old / nloc;
        if (old + 1u == (gen + 1u) * nloc) {
            __builtin_amdgcn_fence(__ATOMIC_RELEASE, "agent");
            asm volatile("s_waitcnt vmcnt(0)" ::: "memory");
            const unsigned og = xb_add(&bar[XB_TOP], 1u);
            const unsigned tg = og / nx;
            if (og + 1u == (tg + 1u) * nx) xb_add(&bar[XB_TOPGEN], 1u);
            else XB_SPIN(xb_ld(&bar[XB_TOPGEN]) == tg, bar);
            __builtin_amdgcn_fence(__ATOMIC_ACQUIRE, "agent");
            xb_add(&bar[XB_XGEN(b.x)], 1u);
            asm volatile("s_waitcnt vmcnt(0)" ::: "memory");
        } else {
            XB_SPIN(xb_ld(&bar[XB_XGEN(b.x)]) == gen, bar);
            __builtin_amdgcn_fence(__ATOMIC_ACQUIRE, "agent");
            asm volatile("s_waitcnt vmcnt(0)" ::: "memory");
        }
    }
    __syncthreads();
}

struct Args { const float* in[19]; float* out; unsigned char* ws; int ph_lo, ph_hi, use_bar, dup; };

__device__ __forceinline__ float wave_sum(float v) {
#pragma unroll
    for (int o = 1; o < 64; o <<= 1) v += __shfl_xor(v, o);
    return v;
}

__device__ __forceinline__ void tr_tile(const float* src, int lds_, bf16* dst, int ldd, LAS float* scr, int lane) {
#pragma unroll 8
    for (int i = 0; i < 32; ++i) { const int kk = 2 * i + (lane >> 5); scr[kk * 33 + (lane & 31)] = src[(size_t)kk * lds_ + (lane & 31)]; }
    LDS_WAIT(); asm volatile("" ::: "memory");
    const int c = lane & 7;
#pragma unroll
    for (int j = 0; j < 4; ++j) { const int n = (lane >> 3) + 8 * j; const LAS float* s = scr + (8 * c) * 33 + n;
        v4u o; o.x = pk2(s[0 * 33], s[1 * 33]); o.y = pk2(s[2 * 33], s[3 * 33]); o.z = pk2(s[4 * 33], s[5 * 33]); o.w = pk2(s[6 * 33], s[7 * 33]);
        *(GAS v4u*)(dst + (size_t)n * ldd + 8 * c) = o; }
    LDS_WAIT(); asm volatile("" ::: "memory");
}
__device__ __forceinline__ void tr_plain(const float* W, int K, int N, bf16* WT, LAS float* scr, int item, int lane) {
    const int nblk = N / 32, kb = item / nblk, nb = item % nblk, k0 = 64 * kb, n0 = 32 * nb;
    tr_tile(W + (size_t)k0 * N + n0, N, WT + (size_t)n0 * K + k0, K, scr, lane);
}
__device__ __forceinline__ void p0_prologue(const Args& a, unsigned char* ws, LAS unsigned char* lds, int vcu, int G, int tid, int lane, int wave) {
    LAS float* scr = (LAS float*)(lds + wave * 8448);
    const int gw = vcu * NWAVES + wave, NGW = G * NWAVES;
    constexpr int I_GU = (D / 64) * (NGU / 32), I_DN = (FF / 64) * (D / 32), I_QKV = (D / 64) * (NQKV / 32), I_O = (D / 64) * (D / 32), I_IN = (D / 64) * (NIN / 32), I_OUT = (DR / 64) * (D / 32), I_G = 2 * 4;
    constexpr int NITEMS = 4 * I_GU + 4 * I_DN + I_QKV + I_O + I_IN + I_OUT + 20 * I_G;
    for (int it = gw; it < NITEMS; it += NGW) {
        int r = it;
        if (r < 4 * I_GU) {
            const int mat = r / I_GU, item = r % I_GU; const int nblk = NGU / 32, kb = item / nblk, nb = item % nblk, k0 = 64 * kb, n0 = 32 * nb;
            const int isu = n0 >= FF ? 1 : 0, ff0 = n0 - isu * FF, L0 = (ff0 >> 7) * 256 + isu * 128 + (ff0 & 127);
            const float* W = a.in[5] + (size_t)mat * D * NGU; bf16* WT = (bf16*)(ws + WS_WGU) + (size_t)mat * NGU * D;
            tr_tile(W + (size_t)k0 * NGU + n0, NGU, WT + (size_t)L0 * D + k0, D, scr, lane); continue; }
        r -= 4 * I_GU;
        if (r < 4 * I_DN) { const int mat = r / I_DN; tr_plain(a.in[6] + (size_t)mat * FF * D, FF, D, (bf16*)(ws + WS_WDN) + (size_t)mat * D * FF, scr, r % I_DN, lane); continue; }
        r -= 4 * I_DN;
        if (r < I_QKV) { tr_plain(a.in[7], D, NQKV, (bf16*)(ws + WS_WQKV), scr, r, lane); continue; } r -= I_QKV;
        if (r < I_O) { tr_plain(a.in[8], D, D, (bf16*)(ws + WS_WO), scr, r, lane); continue; } r -= I_O;
        if (r < I_IN) { tr_plain(a.in[9], D, NIN, (bf16*)(ws + WS_WIN), scr, r, lane); continue; } r -= I_IN;
        if (r < I_OUT) { tr_plain(a.in[17], DR, D, (bf16*)(ws + WS_WOUT), scr, r, lane); continue; } r -= I_OUT;
        { const int mat = r / I_G, item = r % I_G, n = mat >> 1, isi = mat & 1;
          tr_plain((isi ? a.in[14] : a.in[12]) + (size_t)n * 128 * 128, 128, 128, (bf16*)(ws + WS_WRI) + (size_t)n * 256 * 128 + (size_t)isi * 128 * 128, scr, item, lane); }
    }
    __syncthreads();
    LAS float* ca = (LAS float*)lds;
    LAS float* part = (LAS float*)(lds + 32768);
    for (int i = tid; i < BATCH * D; i += NWAVES * 64) { const int b = i / D, k = i % D; const float c = a.in[1][i]; ca[k * 8 + b] = c * __builtin_amdgcn_rcpf(1.0f + __builtin_amdgcn_exp2f(-c * LOG2E)); }
    __syncthreads();
    float* MOD = (float*)(ws + WS_MOD);
    for (int ch = vcu; ch < 2 * NMOD / 72; ch += G) {
        const int g0 = ch * 72, l = g0 / NMOD, j0 = g0 % NMOD;
        const float* W = a.in[2] + (size_t)l * D * NMOD + j0;
        const int rs = lane / 18, cg = lane % 18;
        f32x4 acc[8];
#pragma unroll
        for (int b = 0; b < 8; ++b) acc[b] = (f32x4){0.f, 0.f, 0.f, 0.f};
        if (rs < 3) {
#pragma unroll 4
            for (int i = 0; i < 43; ++i) { const int kl = 3 * i + rs; if (kl < 128) { const int k = wave * 128 + kl;
                const f32x4 w = *(const f32x4*)(W + (size_t)k * NMOD + 4 * cg);
                const f32x4 c0 = *(const LAS f32x4*)(ca + k * 8), c1 = *(const LAS f32x4*)(ca + k * 8 + 4);
                acc[0] += w * c0[0]; acc[1] += w * c0[1]; acc[2] += w * c0[2]; acc[3] += w * c0[3]; acc[4] += w * c1[0]; acc[5] += w * c1[1]; acc[6] += w * c1[2]; acc[7] += w * c1[3]; } }
#pragma unroll
            for (int b = 0; b < 8; ++b) *(LAS f32x4*)(part + ((wave * 3 + rs) * 8 + b) * 72 + 4 * cg) = acc[b];
        }
        __syncthreads();
        for (int o = tid; o < 8 * 72; o += NWAVES * 64) { const int b = o / 72, j = o % 72; float s = a.in[3][(size_t)l * NMOD + j0 + j];
#pragma unroll
            for (int p = 0; p < 24; ++p) s += part[(p * 8 + b) * 72 + j];
            MOD[((size_t)l * BATCH + b) * NMOD + j0 + j] = s; }
        __syncthreads();
    }
}

__device__ __forceinline__ void norm_mod_phase(const float* x, const float* g, const float* shift, const float* scale, bf16* XN, int vcu, int G, int lane, int wave) {
    const int gw = vcu * NWAVES + wave, NGW = G * NWAVES;
    for (int blk = gw; blk < M / 8; blk += NGW) {
        const int row0 = blk * 8, b = row0 / SEQ;
        f32x4 gs[4], sh[4];
#pragma unroll
        for (int j = 0; j < 4; ++j) { const int c = 4 * lane + 256 * j; gs[j] = *(const f32x4*)(g + c) * (*(const f32x4*)(scale + (size_t)b * NMOD + c) + 1.0f); sh[j] = *(const f32x4*)(shift + (size_t)b * NMOD + c); }
#pragma unroll 2
        for (int r = 0; r < 8; ++r) {
            const f32x4* xr = (const f32x4*)(x + (size_t)(row0 + r) * D) + lane;
            f32x4 v[4]; float s = 0.f;
#pragma unroll
            for (int j = 0; j < 4; ++j) { v[j] = xr[64 * j]; s += (v[j].x * v[j].x + v[j].y * v[j].y) + (v[j].z * v[j].z + v[j].w * v[j].w); }
            const float inv = 1.0f / sqrtf(wave_sum(s) * (1.f / D) + RMS_EPS);
            v2u* o8 = (v2u*)(XN + (size_t)(row0 + r) * D) + lane;
#pragma unroll
            for (int j = 0; j < 4; ++j) { const f32x4 h = v[j] * inv * gs[j] + sh[j]; v2u w; w.x = pk2(h.x, h.y); w.y = pk2(h.z, h.w); o8[64 * j] = w; }
        }
    }
}
__device__ __forceinline__ void final_norm_phase(const float* x, const float* g, float* out, int vcu, int G, int lane, int wave) {
    const int gw = vcu * NWAVES + wave, NGW = G * NWAVES;
    f32x4 gs[4];
#pragma unroll
    for (int j = 0; j < 4; ++j) gs[j] = *(const f32x4*)(g + 4 * lane + 256 * j);
    for (int row = gw; row < M; row += NGW) {
        const f32x4* xr = (const f32x4*)(x + (size_t)row * D) + lane;
        f32x4 v[4]; float s = 0.f;
#pragma unroll
        for (int j = 0; j < 4; ++j) { v[j] = xr[64 * j]; s += (v[j].x * v[j].x + v[j].y * v[j].y) + (v[j].z * v[j].z + v[j].w * v[j].w); }
        const float inv = 1.0f / sqrtf(wave_sum(s) * (1.f / D) + RMS_EPS);
        f32x4* o = (f32x4*)(out + (size_t)row * D) + lane;
#pragma unroll
        for (int j = 0; j < 4; ++j) o[64 * j] = v[j] * inv * gs[j];
    }
}

namespace lru {
constexpr int WSTR = 272;
constexpr int OFF_W = 0;
constexpr int OFF_XT = OFF_W + 256 * WSTR;
constexpr int OFF_AT = OFF_XT + 35 * 512;
constexpr int OFF_XC = OFF_AT + 32 * WSTR;
constexpr int OFF_A = OFF_XC + 32 * 512;
constexpr int OFF_B = OFF_A + 32 * 512;
constexpr int OFF_P = OFF_B + 32 * 512;
constexpr int LDS_END = OFF_P + 8 * 512;
static_assert(LDS_END <= MISC_OFF, "lru LDS map");
#define LRU_SYNC() asm volatile("s_waitcnt lgkmcnt(0)\n\ts_barrier" ::: "memory")

template <int PASS> __device__ __forceinline__ void lru_pass(const Args& a, unsigned char* ws, bf16* Yout, LAS unsigned char* lds, int id0, int id1, int tid, int lane, int wave) {
    float* XB = (float*)(ws + WS_XB); const bf16* GG = (const bf16*)(ws + WS_GG); float* SA = (float*)(ws + WS_SA); float* SB = (float*)(ws + WS_SB);
    LAS float* XT = (LAS float*)(lds + OFF_XT); LAS float* XC = (LAS float*)(lds + OFF_XC); LAS float* Aa = (LAS float*)(lds + OFF_A); LAS float* Bb = (LAS float*)(lds + OFF_B); LAS float* P = (LAS float*)(lds + OFF_P);
    int ncur = -1;
    for (int id = id0; id < id1; ++id) {
        const int n = id >> 7, chunk = id & 127;
        const int seq0 = (chunk >> 4) * SEQ;
        const float* xcol = XB + n * 128;
#define LRU_LOADX(dst, r0_) do { _Pragma("unroll") for (int q = 0; q < 3; ++q) { const int i = tid + 512 * q; dst[q] = (f32x4){0.f, 0.f, 0.f, 0.f}; \
            if (i < 35 * 32) { const int grow = (r0_) - 3 + (i >> 5); if (grow >= seq0) dst[q] = *(const f32x4*)(xcol + (size_t)grow * DR + 4 * (i & 31)); } } } while (0)
#define LRU_STOREX(src) do { _Pragma("unroll") for (int q = 0; q < 3; ++q) { const int i = tid + 512 * q; if (i < 35 * 32) *(LAS f32x4*)(XT + (i >> 5) * 128 + 4 * (i & 31)) = src[q]; } } while (0)
        f32x4 xr[3]; v4u gcur = (v4u){0u, 0u, 0u, 0u}, gnext = (v4u){0u, 0u, 0u, 0u};
        const int yrow = tid >> 4, yc8 = (tid & 15) * 8;
        LRU_LOADX(xr, chunk * 128);
        if (PASS == 2) gcur = *(const v4u*)(GG + (size_t)(chunk * 128 + yrow) * DR + n * 128 + yc8);
        if (n != ncur) {
            const bf16* Wg = (const bf16*)(ws + WS_WRI) + (size_t)n * 256 * 128;
            for (int i = tid; i < 256 * 16; i += NWAVES * 64) { const int row = i >> 4, c16 = i & 15; *(LAS v4u*)(lds + OFF_W + row * WSTR + c16 * 16) = *(const v4u*)(Wg + row * 128 + c16 * 8); }
            if (tid < 128) { const int ch = n * 128 + tid;
                P[0 * 128 + tid] = a.in[10][0 * DR + ch]; P[1 * 128 + tid] = a.in[10][1 * DR + ch]; P[2 * 128 + tid] = a.in[10][2 * DR + ch]; P[3 * 128 + tid] = a.in[10][3 * DR + ch];
                P[4 * 128 + tid] = a.in[11][ch]; P[5 * 128 + tid] = a.in[13][ch] * LOG2E; P[6 * 128 + tid] = a.in[15][ch] * LOG2E; P[7 * 128 + tid] = 8.0f * log1pf(expf(-a.in[16][ch])); }
            ncur = n;
        }
        float h = 0.f, Ac = 1.f;
        if (PASS == 2 && tid < 128) { const int cs = chunk & 15, c0 = chunk - cs;
            for (int c = 0; c < cs; ++c) { const size_t idx = (size_t)(c0 + c) * DR + n * 128 + tid; h = SA[idx] * h + SB[idx]; } }
        LRU_STOREX(xr);
        LRU_LOADX(xr, chunk * 128 + 32);
        __syncthreads();
#pragma unroll 1
        for (int sub = 0; sub < 4; ++sub) {
            const int r0 = chunk * 128 + sub * 32;
            if (PASS == 2 && sub < 3) gnext = *(const v4u*)(GG + (size_t)(r0 + 32 + yrow) * DR + n * 128 + yc8);
            { const int row = tid >> 4, c8 = (tid & 15) * 8; float xc[8];
#pragma unroll
              for (int e = 0; e < 8; ++e) { const int ch = c8 + e; float s = P[4 * 128 + ch];
#pragma unroll
                  for (int tap = 0; tap < 4; ++tap) s += XT[(row + tap) * 128 + ch] * P[tap * 128 + ch];
                  xc[e] = s; }
              *(LAS f32x4*)(XC + row * 128 + c8) = (f32x4){xc[0], xc[1], xc[2], xc[3]}; *(LAS f32x4*)(XC + row * 128 + c8 + 4) = (f32x4){xc[4], xc[5], xc[6], xc[7]};
              v4u o; o.x = pk2(xc[0], xc[1]); o.y = pk2(xc[2], xc[3]); o.z = pk2(xc[4], xc[5]); o.w = pk2(xc[6], xc[7]);
              *(LAS v4u*)(lds + OFF_AT + row * WSTR + c8 * 2) = o; }
            LRU_SYNC();
            if (sub < 3) { LRU_STOREX(xr); if (sub < 2) LRU_LOADX(xr, r0 + 64); }
            { const int rg = wave & 1, cq = wave >> 1, fr = lane & 15, fq = lane >> 4;
              f32x4 acc[4];
#pragma unroll
              for (int t = 0; t < 4; ++t) acc[t] = (f32x4){0.f, 0.f, 0.f, 0.f};
#pragma unroll
              for (int ks = 0; ks < 4; ++ks) { const bf16x8 af = *(const LAS bf16x8*)(lds + OFF_AT + (16 * rg + fr) * WSTR + (32 * ks + 8 * fq) * 2);
#pragma unroll
                  for (int t = 0; t < 4; ++t) { const int orow = (t >> 1) * 128 + 32 * cq + 16 * (t & 1) + fr; const bf16x8 bfg = *(const LAS bf16x8*)(lds + OFF_W + orow * WSTR + (32 * ks + 8 * fq) * 2);
                      acc[t] = __builtin_amdgcn_mfma_f32_16x16x32_bf16(bfg, af, acc[t], 0, 0, 0); } }
              const int row = 16 * rg + fr;
#pragma unroll
              for (int tt = 0; tt < 2; ++tt) { const int ch0 = 32 * cq + 16 * tt + 4 * fq;
                  const f32x4 br = *(const LAS f32x4*)(P + 5 * 128 + ch0), bi = *(const LAS f32x4*)(P + 6 * 128 + ch0), sp = *(const LAS f32x4*)(P + 7 * 128 + ch0), xcv = *(const LAS f32x4*)(XC + row * 128 + ch0);
                  f32x4 av, bv;
#pragma unroll
                  for (int e = 0; e < 4; ++e) {
                      const float r = __builtin_amdgcn_rcpf(1.0f + __builtin_amdgcn_exp2f(-(acc[tt][e] * LOG2E + br[e]))), ig = __builtin_amdgcn_rcpf(1.0f + __builtin_amdgcn_exp2f(-(acc[2 + tt][e] * LOG2E + bi[e])));
                      const float la = -r * sp[e], aa = __builtin_amdgcn_exp2f(la * LOG2E), t = 2.0f * la;
                      const float em_small = -t * (1.0f + t * (0.5f + t * (0.16666667f + t * (0.041666668f + t * 0.0083333338f)))), em = (t > -0.25f) ? em_small : (1.0f - aa * aa);
                      av[e] = aa; bv[e] = __builtin_amdgcn_sqrtf(em) * (ig * xcv[e]); }
                  *(LAS f32x4*)(Aa + row * 128 + ch0) = av; *(LAS f32x4*)(Bb + row * 128 + ch0) = bv; } }
            LRU_SYNC();
            if (tid < 128) {
                float av[32], bv[32];
#pragma unroll
                for (int r = 0; r < 32; ++r) { av[r] = Aa[r * 128 + tid]; bv[r] = Bb[r * 128 + tid]; }
#pragma unroll
                for (int r = 0; r < 32; ++r) { h = av[r] * h + bv[r]; Ac *= av[r]; bv[r] = h; }
                if (PASS == 2) {
#pragma unroll
                    for (int r = 0; r < 32; ++r) Bb[r * 128 + tid] = bv[r]; } }
            if (PASS == 2) {
                LRU_SYNC();
                const LAS float* hp = Bb + yrow * 128 + yc8; const f32x4 h0 = *(const LAS f32x4*)hp, h1 = *(const LAS f32x4*)(hp + 4);
                v4u o;
                o.x = pk2(bf2f((unsigned short)(gcur.x & 0xffffu)) * h0[0], bf2f((unsigned short)(gcur.x >> 16)) * h0[1]); o.y = pk2(bf2f((unsigned short)(gcur.y & 0xffffu)) * h0[2], bf2f((unsigned short)(gcur.y >> 16)) * h0[3]);
                o.z = pk2(bf2f((unsigned short)(gcur.z & 0xffffu)) * h1[0], bf2f((unsigned short)(gcur.z >> 16)) * h1[1]); o.w = pk2(bf2f((unsigned short)(gcur.w & 0xffffu)) * h1[2], bf2f((unsigned short)(gcur.w >> 16)) * h1[3]);
                *(v4u*)(Yout + (size_t)(r0 + yrow) * DR + n * 128 + yc8) = o;
                gcur = gnext;
            }
        }
        if (PASS == 1 && tid < 128) { const size_t idx = (size_t)chunk * DR + n * 128 + tid; SA[idx] = Ac; SB[idx] = h; }
        __syncthreads();
#undef LRU_LOADX
#undef LRU_STOREX
    }
}
#undef LRU_SYNC
}

enum { PH_PROLOGUE = 0, PH_NORM, PH_GU, PH_DOWN, PH_QKV, PH_ATTN, PH_WO, PH_WIN, PH_LRU1, PH_LRU2, PH_WOUT, PH_FINAL };
constexpr int NPHASES = 23;
__constant__ unsigned char PH_KIND[NPHASES] = { PH_PROLOGUE,
    PH_NORM, PH_GU, PH_DOWN,  PH_NORM, PH_QKV, PH_ATTN, PH_WO,            PH_NORM, PH_GU, PH_DOWN,
    PH_NORM, PH_GU, PH_DOWN,  PH_NORM, PH_WIN, PH_LRU1, PH_LRU2, PH_WOUT, PH_NORM, PH_GU, PH_DOWN,
    PH_FINAL };
__constant__ unsigned char PH_LAYER[NPHASES] = { 0, 0,0,0, 0,0,0,0, 0,0,0, 1,1,1, 1,1,1,1,1, 1,1,1, 1 };
__constant__ unsigned char PH_SUB[NPHASES]   = { 0, 0,0,0, 1,1,1,1, 2,2,2, 0,0,0, 1,1,1,1,1, 2,2,2, 0 };

__global__ void __launch_bounds__(NWAVES * 64, 2) fwd_kernel(Args args) {
    extern __shared__ __attribute__((aligned(16))) unsigned char lds_raw[];
    LAS unsigned char* lds = (LAS unsigned char*)lds_raw;
    volatile LAS unsigned* MISC = (volatile LAS unsigned*)(lds + MISC_OFF);
    const int tid0 = threadIdx.x;
    const int G = gridDim.x; const int bx = blockIdx.x; const int vcu = (G % 8 == 0) ? (bx % 8) * (G / 8) + bx / 8 : bx;
    unsigned char* ws0 = args.ws;
    gu32* ctl = (gu32*)(ws0 + WS_CTL);
    for (int u = tid0; u < 64; u += NWAVES * 64) MISC[u] = 0u;
    __syncthreads();
    XcdBarrier bar; bar.bar = (unsigned*)(ctl + CW_BAR); bar.x = 0; bar.st = nullptr;
    if (args.use_bar) bar = xcd_barrier_post((unsigned*)(ctl + CW_BAR), MISC + 8);

    float* X = args.out;

    for (int ph = args.ph_lo; ph < args.ph_hi; ++ph) {
        const int kind = PH_KIND[ph], l = PH_LAYER[ph], sub = PH_SUB[ph];
        const int reps = ((args.dup >> kind) & 1) ? 2 : 1;
        for (int rep = 0; rep < reps; ++rep) {
        int tid = tid0; asm volatile("" : "+v"(tid)); GAS unsigned char* wsg = (GAS unsigned char*)ws0; asm volatile("" : "+s"(wsg)); unsigned char* ws = (unsigned char*)wsg;
        const int lane = tid & 63, wave = __builtin_amdgcn_readfirstlane(tid >> 6);
        float* MOD = (float*)(ws + WS_MOD); bf16* XN = (bf16*)(ws + WS_XN);
        const float* modl = MOD + (size_t)l * BATCH * NMOD + (size_t)sub * 3 * D;
        const int fidx = l * 2 + (sub == 2 ? 1 : 0);
        const bool dry = rep + 1 < reps;
        if (kind == PH_PROLOGUE) {
            p0_prologue(args, ws, lds, vcu, G, tid, lane, wave);
        } else if (kind == PH_NORM) {
            const float* xin = (ph == 1) ? args.in[0] : X;
            norm_mod_phase(xin, args.in[4] + (size_t)(l * 3 + sub) * D, modl, modl + D, XN, vcu, G, lane, wave);
        } else if (kind == PH_GU) {
            pg8::Gemm g{XN, (const bf16*)(ws + WS_WGU) + (size_t)fidx * NGU * D, M, NGU, D}; pg8::StaticOrder S; S.init(M, NGU, G, bx);
            pg8::EpiSwiglu E{(bf16*)(ws + WS_ACT), FF};
            pg8::gemm_phase<pg8::EpiSwiglu, pg8::StaticOrder, true, true>(lds + RING_OFF, g, S, E);
        } else if (kind == PH_DOWN || kind == PH_WO || kind == PH_WOUT) {
            const bf16* A; const bf16* Bt; int K; float mw;
            if (kind == PH_DOWN) { A = (const bf16*)(ws + WS_ACT); Bt = (const bf16*)(ws + WS_WDN) + (size_t)fidx * D * FF; K = FF; mw = 0.5f; }
            else if (kind == PH_WO) { A = (const bf16*)(ws + WS_QO); Bt = (const bf16*)(ws + WS_WO); K = D; mw = 1.0f; }
            else { A = (const bf16*)(ws + WS_GG); Bt = (const bf16*)(ws + WS_WOUT); K = DR; mw = 1.0f; }
            const float* base = (ph == 3) ? args.in[0] : X;
            pg8::Gemm g{A, Bt, M, D, K}; pg8::StaticOrder S; S.init(M, D, G, bx);
            pg8::EpiResid E{base, dry ? (float*)(ws + WS_SCR) : X, D, modl + 2 * D, NMOD, mw};
            pg8::gemm_phase<pg8::EpiResid, pg8::StaticOrder, true, true>(lds + RING_OFF, g, S, E);
        } else if (kind == PH_QKV) {
            pg8::Gemm g{XN, (const bf16*)(ws + WS_WQKV), M, NQKV, D}; pg8::StaticOrder S; S.init(M, NQKV, G, bx);
            pg8::EpiQKV E{(bf16*)(ws + WS_QO), D, D, (size_t)(WS_K - WS_QO) / 2, 0.125f * LOG2E};
            pg8::gemm_phase<pg8::EpiQKV, pg8::StaticOrder, true, true>(lds + RING_OFF, g, S, E);
        } else if (kind == PH_ATTN) {
            const sba::bf16* Qp = (const sba::bf16*)(ws + WS_QO); const sba::bf16* Kp = (const sba::bf16*)(ws + WS_K); const sba::bf16* Vp = (const sba::bf16*)(ws + WS_V);
            sba::bf16* Op = (sba::bf16*)(ws + (dry ? WS_SCR : WS_QO));
            if (G == 256) {
                const int bh = vcu >> 1, hf = vcu & 1;
                for (int i = 0; i < 4; ++i) { const int qb = (i == 0) ? 7 - hf : (i == 1) ? hf : (i == 2) ? 5 - hf : 2 + hf;
                    sba::attn_unit(bh / NH, bh % NH, qb, Qp, Kp, Vp, Op, (LAS char*)(lds + RING_OFF)); }
            } else {
                for (int it = vcu; it < BATCH * NH * 8; it += G) sba::attn_unit((it >> 3) / NH, (it >> 3) % NH, it & 7, Qp, Kp, Vp, Op, (LAS char*)(lds + RING_OFF));
            }
        } else if (kind == PH_WIN) {
            pg8::Gemm g{XN, (const bf16*)(ws + WS_WIN), M, NIN, D}; pg8::StaticOrder S; S.init(M, NIN, G, bx);
            pg8::EpiLruIn E{(bf16*)(ws + WS_GG), (float*)(ws + WS_XB), DR};
            pg8::gemm_phase<pg8::EpiLruIn, pg8::StaticOrder, true, true>(lds + RING_OFF, g, S, E);
        } else if (kind == PH_LRU1) {
            { const int upw = (1280 + G - 1) / G, id0 = vcu * upw, id1 = (id0 + upw < 1280) ? id0 + upw : 1280; lru::lru_pass<1>(args, ws, nullptr, lds, id0, id1, tid, lane, wave); }
        } else if (kind == PH_LRU2) {
            { const int upw = (1280 + G - 1) / G, id0 = vcu * upw, id1 = (id0 + upw < 1280) ? id0 + upw : 1280; lru::lru_pass<2>(args, ws, (bf16*)(ws + (dry ? WS_SCR : WS_GG)), lds, id0, id1, tid, lane, wave); }
        } else {
            final_norm_phase(X, args.in[18], dry ? (float*)(ws + WS_SCR) : X, vcu, G, lane, wave);
        }
        if (dry) xcd_barrier(bar);
        }
        if (ph + 1 < args.ph_hi) xcd_barrier(bar);
    }
}

extern "C" void kernel_launch(void* const* d_in, const int* in_sizes, int n_in, void* d_out, int out_size, void* d_ws, size_t ws_size, hipStream_t stream) {
    static int grid = 0;
    if (grid == 0) {
        if (n_in != 19 || in_sizes[0] != M * D || out_size != M * D || ws_size < WS_SCR_END) { fprintf(stderr, "kernel_launch: unexpected shapes (n_in %d, in0 %d, out %d, ws %zu); nothing launched\n", n_in, n_in > 0 ? in_sizes[0] : -1, out_size, ws_size); grid = -1; return; }
        int dev = 0, cus = 0, per_cu = 0;
        if (hipGetDevice(&dev) != hipSuccess || hipDeviceGetAttribute(&cus, hipDeviceAttributeMultiprocessorCount, dev) != hipSuccess) { fprintf(stderr, "kernel_launch: device query failed\n"); grid = -1; return; }
        if (hipFuncSetAttribute((const void*)fwd_kernel, hipFuncAttributeMaxDynamicSharedMemorySize, LDS_BYTES) != hipSuccess) { fprintf(stderr, "kernel_launch: hipFuncSetAttribute failed\n"); grid = -1; return; }
        if (hipOccupancyMaxActiveBlocksPerMultiprocessor(&per_cu, (const void*)fwd_kernel, NWAVES * 64, LDS_BYTES) != hipSuccess || per_cu < 1)
            fprintf(stderr, "kernel_launch: note: occupancy query reports %d workgroups per CU\n", per_cu);
        (void)hipGetLastError();
        grid = cus;
    }
    if (grid < 0) return;
    if (hipMemsetAsync((char*)d_ws + WS_CTL, 0, CTL_ZERO_BYTES, stream) != hipSuccess) { fprintf(stderr, "kernel_launch: hipMemsetAsync failed\n"); return; }
    Args a{};
    for (int i = 0; i < 19; ++i) a.in[i] = (const float*)d_in[i];
    a.out = (float*)d_out; a.ws = (unsigned char*)d_ws; a.dup = PROBE_DUP;
#if MK_ONE_LAUNCH
    a.ph_lo = 0; a.ph_hi = NPHASES; a.use_bar = 1;
    hipLaunchKernelGGL(fwd_kernel, dim3(grid), dim3(NWAVES * 64), LDS_BYTES, stream, a);
#else
    for (int ph = 0; ph < NPHASES; ++ph) { a.ph_lo = ph; a.ph_hi = ph + 1; a.use_bar = 0;
        hipLaunchKernelGGL(fwd_kernel, dim3(grid), dim3(NWAVES * 64), LDS_BYTES, stream, a); }
#endif
    const hipError_t le = hipPeekAtLastError();
    if (le != hipSuccess) fprintf(stderr, "kernel_launch: launch failed: %s\n", hipGetErrorName(le));
}
```

```cpp
#include <hip/hip_runtime.h>
#include <hip/hip_bf16.h>
#include <cstdio>
#include <cstdint>
#include <cmath>

#ifndef PROBE_DUP
#define PROBE_DUP 0
#endif
#ifndef MK_ONE_LAUNCH
#define MK_ONE_LAUNCH 1
#endif

constexpr int BATCH = 8, SEQ = 2048, D = 1024, M = BATCH * SEQ, FF = 2816, NGU = 2 * FF, NQKV = 3 * D, DR = 1280, NIN = 2 * DR, NMOD = 9 * D, NH = 16, HD = 64;
constexpr float RMS_EPS = 1e-6f;
constexpr float LOG2E = 1.4426950408889634f;

__device__ __forceinline__ int opaque_tid() { int t = threadIdx.x; asm volatile("" : "+v"(t)); return t; }


namespace pg8 {
#define PG8_LAS __attribute__((address_space(3)))
typedef unsigned short bf16_t;
typedef short bf16x8 __attribute__((ext_vector_type(8)));
typedef float f32x4 __attribute__((ext_vector_type(4)));
typedef unsigned u32x4 __attribute__((ext_vector_type(4)));
constexpr int BM = 256, BK = 64, HALF = 128, HTB = HALF * BK * 2  , STAGE_BYTES = 8 * HTB, NXCD = 8, WGM = 8;

__host__ __device__ __forceinline__ int lds_byte(int r, int c) { const int st = (r >> 4) * 2 + (c >> 5), rr = r & 15, cc = c & 31, ob = rr * 64 + cc * 2; return st * 1024 + (ob ^ (((ob >> 9) & 1) << 5)); }
__host__ __device__ __forceinline__ void stage_rc(int b, int& R, int& C) { const int st = b / 1024, sb = b % 1024, swz = sb ^ (((sb >> 9) & 1) << 5); R = (st >> 1) * 16 + swz / 64; C = (st & 1) * 32 + (swz % 64) / 2; }
__host__ __device__ __forceinline__ int perm32(int rho) { const int n = rho >> 4, i = rho & 15; return 8 * (i >> 2) + 4 * n + (i & 3); }

struct Unit { int pm, pn; };
struct Gemm { const bf16_t* A; const bf16_t* Bt; int M, N, K; };

struct StaticOrder {
    int nM, nN, nwg, G, c;
    __host__ __device__ void init(int M, int N, int G_, int c_) { nM = M / BM; nN = N / BM; nwg = nM * nN; G = G_; c = c_; }
    __host__ __device__ bool next(int i, Unit& u) const {
        const long L = (long)i * G + c; if (L >= nwg) return false;
        int wgid = (int)L; { const int q = nwg / NXCD, r = nwg % NXCD, xcd = wgid % NXCD, off = wgid / NXCD; wgid = (xcd < r ? xcd * (q + 1) : r * (q + 1) + (xcd - r) * q) + off; }
        const int nig = WGM * nN, gid = wgid / nig, fm = gid * WGM, gsz = (nM - fm) < WGM ? (nM - fm) : WGM;
        u.pm = fm + ((wgid % nig) % gsz); u.pn = (wgid % nig) / gsz; return true;
    }
    __device__ __forceinline__ void a_ready(const Unit&) const {}
    __device__ __forceinline__ void done(const Unit&) const {}
};

__device__ __forceinline__ unsigned cvt_pk_bf16(float lo, float hi) { unsigned r; asm volatile("v_cvt_pk_bf16_f32 %0, %1, %2" : "=v"(r) : "v"(lo), "v"(hi)); return r; }
typedef unsigned u32x2 __attribute__((ext_vector_type(2)));

struct EpiQKV {
    static constexpr bool PERM = true, AFTER_DRAIN = false;
    bf16_t* O; int ldc; int split_cols; size_t split_stride; float scale0;
    __device__ __forceinline__ void operator()(const f32x4 (&acc)[2][2][4][2], const Unit& u, int wr, int wc, int fr, int fq) const {
        const int row0 = u.pm * BM + wr * 64 + fr; int colt = u.pn * BM; bf16_t* base = O;
        float sc = 1.f; { const int t = colt / split_cols; base += (size_t)t * split_stride; colt -= t * split_cols; if (t == 0) sc = scale0; }
        const int col0 = colt + wc * 32 + 8 * fq;
#pragma unroll
        for (int ai = 0; ai < 2; ++ai)
#pragma unroll
            for (int m = 0; m < 4; ++m) { bf16_t* rowp = base + (size_t)(row0 + ai * HALF + m * 16) * ldc + col0;
#pragma unroll
                for (int bj = 0; bj < 2; ++bj) { f32x4 v0 = acc[ai][bj][m][0] * sc, v1 = acc[ai][bj][m][1] * sc;
                    u32x4 w; w.x = cvt_pk_bf16(v0[0], v0[1]); w.y = cvt_pk_bf16(v0[2], v0[3]); w.z = cvt_pk_bf16(v1[0], v1[1]); w.w = cvt_pk_bf16(v1[2], v1[3]);
                    *(u32x4*)(rowp + bj * HALF) = w; } }
    }
};

__device__ __forceinline__ float silu_mul(float g, float u) { return g * __builtin_amdgcn_rcpf(1.0f + __builtin_amdgcn_exp2f(-g * 1.4426950408889634f)) * u; }
struct EpiSwiglu {
    static constexpr bool PERM = true, AFTER_DRAIN = false;
    bf16_t* O; int ldc;
    __device__ __forceinline__ void operator()(const f32x4 (&acc)[2][2][4][2], const Unit& u, int wr, int wc, int fr, int fq) const {
        const int row0 = u.pm * BM + wr * 64 + fr, col0 = u.pn * HALF + wc * 32 + 8 * fq;
#pragma unroll
        for (int ai = 0; ai < 2; ++ai)
#pragma unroll
            for (int m = 0; m < 4; ++m) { bf16_t* rowp = O + (size_t)(row0 + ai * HALF + m * 16) * ldc + col0;
                const f32x4 g0 = acc[ai][0][m][0], g1 = acc[ai][0][m][1], u0 = acc[ai][1][m][0], u1 = acc[ai][1][m][1];
                u32x4 w;
                w.x = cvt_pk_bf16(silu_mul(g0[0], u0[0]), silu_mul(g0[1], u0[1])); w.y = cvt_pk_bf16(silu_mul(g0[2], u0[2]), silu_mul(g0[3], u0[3]));
                w.z = cvt_pk_bf16(silu_mul(g1[0], u1[0]), silu_mul(g1[1], u1[1])); w.w = cvt_pk_bf16(silu_mul(g1[2], u1[2]), silu_mul(g1[3], u1[3]));
                *(u32x4*)rowp = w; }
    }
};

struct EpiResid {
    static constexpr bool PERM = false, AFTER_DRAIN = false;
    const float* base; float* out; int ldc; const float* gate; int gstride; float mw;
    __device__ __forceinline__ void operator()(const f32x4 (&acc)[2][2][4][2], const Unit& u, int wr, int wc, int fr, int fq) const {
        const int row0 = u.pm * BM + wr * 64 + fr, col0 = u.pn * BM + wc * 32 + 4 * fq;
        const float* gp = gate + (size_t)(u.pm >> 3) * gstride + col0;
        f32x4 gv[2][2];
#pragma unroll
        for (int bj = 0; bj < 2; ++bj)
#pragma unroll
            for (int n = 0; n < 2; ++n) gv[bj][n] = (*(const f32x4*)(gp + bj * HALF + n * 16) + 1.0f) * mw;
#pragma unroll
        for (int ai = 0; ai < 2; ++ai)
#pragma unroll
            for (int m = 0; m < 4; ++m) { const size_t off = (size_t)(row0 + ai * HALF + m * 16) * ldc + col0;
#pragma unroll
                for (int bj = 0; bj < 2; ++bj)
#pragma unroll
                    for (int n = 0; n < 2; ++n) { const f32x4 bs = *(const f32x4*)(base + off + bj * HALF + n * 16); *(f32x4*)(out + off + bj * HALF + n * 16) = bs + gv[bj][n] * acc[ai][bj][m][n]; } }
    }
};

__device__ __forceinline__ float gelu_tanh(float x) { const float y = x * (1.5957691216057308f + 0.0713548162726f * x * x); return x * __builtin_amdgcn_rcpf(1.0f + __builtin_amdgcn_exp2f(-y * 1.4426950408889634f)); }
struct EpiLruIn {
    static constexpr bool PERM = false, AFTER_DRAIN = false;
    bf16_t* GG; float* XB; int ldc;
    __device__ __forceinline__ void operator()(const f32x4 (&acc)[2][2][4][2], const Unit& u, int wr, int wc, int fr, int fq) const {
        const int row0 = u.pm * BM + wr * 64 + fr;
        if (u.pn < 5) {
            const int col0 = u.pn * BM + wc * 32 + 4 * fq;
#pragma unroll
            for (int ai = 0; ai < 2; ++ai)
#pragma unroll
                for (int m = 0; m < 4; ++m) { bf16_t* rowp = GG + (size_t)(row0 + ai * HALF + m * 16) * ldc + col0;
#pragma unroll
                    for (int bj = 0; bj < 2; ++bj)
#pragma unroll
                        for (int n = 0; n < 2; ++n) { const f32x4 v = acc[ai][bj][m][n]; u32x2 w; w.x = cvt_pk_bf16(gelu_tanh(v[0]), gelu_tanh(v[1])); w.y = cvt_pk_bf16(gelu_tanh(v[2]), gelu_tanh(v[3]));
                            *(u32x2*)(rowp + bj * HALF + n * 16) = w; } }
        } else {
            const int col0 = (u.pn - 5) * BM + wc * 32 + 4 * fq;
#pragma unroll
            for (int ai = 0; ai < 2; ++ai)
#pragma unroll
                for (int m = 0; m < 4; ++m) { float* rowp = XB + (size_t)(row0 + ai * HALF + m * 16) * ldc + col0;
#pragma unroll
                    for (int bj = 0; bj < 2; ++bj)
#pragma unroll
                        for (int n = 0; n < 2; ++n) *(f32x4*)(rowp + bj * HALF + n * 16) = acc[ai][bj][m][n]; }
        }
    }
};

template <class Epi, class Sched, bool ALIGN_EPI = false, bool SP2 = false>
__device__ __forceinline__ void gemm_phase(PG8_LAS unsigned char* lds, const Gemm g, const Sched& S, const Epi& E) {
    const int tid = opaque_tid(), wid = __builtin_amdgcn_readfirstlane(tid >> 6), lane = tid & 63, wr = wid >> 2, wc = wid & 3, fr = lane & 15, fq = lane >> 4;
    const int K = g.K, nt = K / BK;
    unsigned voffA[2], voffB[2];
#pragma unroll
    for (int i = 0; i < 2; ++i) { int R, C; stage_rc(tid * 16 + i * 8192, R, C); const int Rb = Epi::PERM ? ((R & ~31) + perm32(R & 31)) : R;
        voffA[i] = (unsigned)(R * K + C) * 2u; voffB[i] = (unsigned)(Rb * K + C) * 2u; }
    const size_t kstep = (size_t)(BK * 2);
    const size_t hstep = (size_t)HALF * K * 2;
    const size_t tstep = 2 * hstep;
    const unsigned ldsw = (unsigned)wid * 1024u;
    const int aoff = lds_byte(wr * 64 + fr, fq * 8), boff = lds_byte(wc * 32 + fr, fq * 8);
#define PG8_SA(b, h) (((b) * 2 + (h)) * HTB)
#define PG8_SB(b, h) ((4 + (b) * 2 + (h)) * HTB)
#define PG8_STAGE(bufoff, gbase, voff) do { _Pragma("unroll") for (int _i = 0; _i < 2; ++_i) \
        __builtin_amdgcn_global_load_lds((const unsigned*)((const char*)(gbase) + (voff)[_i]), (PG8_LAS unsigned*)(lds + (bufoff) + ldsw + _i * 8192), 16, 0, 0); } while (0)
#define PG8_LDA(dst, b, h) do { _Pragma("unroll") for (int m = 0; m < 4; ++m) _Pragma("unroll") for (int k = 0; k < 2; ++k) dst[m][k] = *(const PG8_LAS bf16x8*)(lds + PG8_SA(b, h) + aoff + m * 2048 + k * 1024); } while (0)
#define PG8_LDB(dst, b, h) do { _Pragma("unroll") for (int n = 0; n < 2; ++n) _Pragma("unroll") for (int k = 0; k < 2; ++k) dst[n][k] = *(const PG8_LAS bf16x8*)(lds + PG8_SB(b, h) + boff + n * 2048 + k * 1024); } while (0)
#define PG8_MMA(ai, bj, At, Bt) do { __builtin_amdgcn_s_setprio(1); _Pragma("unroll") for (int m = 0; m < 4; ++m) _Pragma("unroll") for (int n = 0; n < 2; ++n) _Pragma("unroll") for (int k = 0; k < 2; ++k) \
        acc[ai][bj][m][n] = __builtin_amdgcn_mfma_f32_16x16x32_bf16(Bt[n][k], At[m][k], acc[ai][bj][m][n], 0, 0, 0); __builtin_amdgcn_s_setprio(0); } while (0)
#define PG8_WAIT_V(n) asm volatile("s_waitcnt vmcnt(" #n ")" ::: "memory")
#define PG8_WAIT_L(n) asm volatile("s_waitcnt lgkmcnt(" #n ")" ::: "memory")
#define PG8_BAR __builtin_amdgcn_s_barrier()
#define PG8_SCHED __builtin_amdgcn_sched_barrier(0)
    Unit cur, nxt; int ui = 0;
    if (!S.next(0, cur)) return;
    f32x4 acc[2][2][4][2];
#pragma unroll
    for (int a = 0; a < 2; ++a)
#pragma unroll
        for (int b = 0; b < 2; ++b)
#pragma unroll
            for (int m = 0; m < 4; ++m)
#pragma unroll
                for (int n = 0; n < 2; ++n) acc[a][b][m][n] = (f32x4){0.f, 0.f, 0.f, 0.f};
    bf16x8 At[4][2], B0[2][2], B1[2][2];
    const char* cA = (const char*)g.A + (size_t)cur.pm * tstep; const char* cB = (const char*)g.Bt + (size_t)cur.pn * tstep;
    S.a_ready(cur);
    if constexpr (SP2) {
        PG8_STAGE(PG8_SB(0, 0), cB, voffB); PG8_STAGE(PG8_SB(0, 1), cB + hstep, voffB); PG8_STAGE(PG8_SA(0, 0), cA, voffA); PG8_STAGE(PG8_SA(0, 1), cA + hstep, voffA);
        if (wr == 1) PG8_BAR;
        PG8_WAIT_V(2); PG8_BAR;
        PG8_STAGE(PG8_SB(1, 0), cB + kstep, voffB); PG8_STAGE(PG8_SA(1, 0), cA + kstep, voffA); PG8_STAGE(PG8_SB(1, 1), cB + hstep + kstep, voffB);
        PG8_WAIT_V(6); PG8_BAR;
    } else {
        PG8_STAGE(PG8_SB(0, 0), cB, voffB); PG8_STAGE(PG8_SA(0, 0), cA, voffA); PG8_STAGE(PG8_SB(0, 1), cB + hstep, voffB); PG8_STAGE(PG8_SA(0, 1), cA + hstep, voffA);
        if (wr == 1) PG8_BAR;
        PG8_WAIT_V(4); PG8_BAR;
        PG8_STAGE(PG8_SB(1, 0), cB + kstep, voffB); PG8_STAGE(PG8_SA(1, 0), cA + kstep, voffA); PG8_STAGE(PG8_SB(1, 1), cB + hstep + kstep, voffB);
        PG8_WAIT_V(6); PG8_BAR;
    }
    for (;;) {
        const bool has_next = S.next(ui + 1, nxt);
        const char* nA = has_next ? (const char*)g.A + (size_t)nxt.pm * tstep : cA; const char* nB = has_next ? (const char*)g.Bt + (size_t)nxt.pn * tstep : cB;
        for (int t = 0; t < nt; t += 2) {
            const bool last = (t == nt - 2);
            const char* a1 = cA + (size_t)(t + 1) * kstep;
            const char* a2 = last ? nA : cA + (size_t)(t + 2) * kstep; const char* b2 = last ? nB : cB + (size_t)(t + 2) * kstep;
            const char* a3 = a2 + kstep; const char* b3 = b2 + kstep;
            if (last && has_next) S.a_ready(nxt);
            if constexpr (SP2) {
            PG8_LDB(B0, 0, 0); PG8_LDB(B1, 0, 1); PG8_SCHED; PG8_LDA(At, 0, 0); PG8_STAGE(PG8_SA(1, 1), a1 + hstep, voffA);
            PG8_WAIT_V(8); PG8_WAIT_L(0); PG8_BAR; PG8_MMA(0, 0, At, B0); PG8_MMA(0, 1, At, B1); PG8_BAR; PG8_SCHED;
            PG8_LDA(At, 0, 1); PG8_STAGE(PG8_SB(0, 0), b2, voffB); PG8_STAGE(PG8_SB(0, 1), b2 + hstep, voffB); PG8_STAGE(PG8_SA(0, 0), a2, voffA);
            PG8_WAIT_V(8); PG8_WAIT_L(0); PG8_BAR; PG8_MMA(1, 0, At, B0); PG8_MMA(1, 1, At, B1); PG8_BAR; PG8_SCHED;
            PG8_LDB(B0, 1, 0); PG8_LDB(B1, 1, 1); PG8_SCHED; PG8_LDA(At, 1, 0); PG8_STAGE(PG8_SA(0, 1), a2 + hstep, voffA);
            PG8_WAIT_V(8); PG8_WAIT_L(0); PG8_BAR; PG8_MMA(0, 0, At, B0); PG8_MMA(0, 1, At, B1); PG8_BAR; PG8_SCHED;
            PG8_LDA(At, 1, 1); PG8_STAGE(PG8_SB(1, 0), b3, voffB); PG8_STAGE(PG8_SB(1, 1), b3 + hstep, voffB); PG8_STAGE(PG8_SA(1, 0), a3, voffA);
            PG8_WAIT_V(8); PG8_WAIT_L(0); PG8_BAR; PG8_MMA(1, 0, At, B0); PG8_MMA(1, 1, At, B1); PG8_BAR; PG8_SCHED;
            } else {
            PG8_LDB(B0, 0, 0); PG8_SCHED; PG8_LDA(At, 0, 0); PG8_STAGE(PG8_SA(1, 1), a1 + hstep, voffA);
            PG8_WAIT_L(8); PG8_BAR; PG8_WAIT_L(0); PG8_MMA(0, 0, At, B0); PG8_BAR; PG8_SCHED;
            PG8_LDB(B1, 0, 1); PG8_STAGE(PG8_SB(0, 0), b2, voffB);
            PG8_BAR; PG8_WAIT_L(0); PG8_MMA(0, 1, At, B1); PG8_BAR;
            PG8_LDA(At, 0, 1); PG8_STAGE(PG8_SA(0, 0), a2, voffA);
            PG8_BAR; PG8_WAIT_L(0); PG8_MMA(1, 0, At, B0); PG8_BAR; PG8_SCHED;
            PG8_STAGE(PG8_SB(0, 1), b2 + hstep, voffB);
            PG8_WAIT_V(6); PG8_BAR; PG8_MMA(1, 1, At, B1); PG8_BAR;
            PG8_LDB(B0, 1, 0); PG8_SCHED; PG8_LDA(At, 1, 0); PG8_STAGE(PG8_SA(0, 1), a2 + hstep, voffA);
            PG8_WAIT_L(8); PG8_BAR; PG8_WAIT_L(0); PG8_MMA(0, 0, At, B0); PG8_BAR; PG8_SCHED;
            PG8_LDB(B1, 1, 1); PG8_STAGE(PG8_SB(1, 0), b3, voffB);
            PG8_BAR; PG8_WAIT_L(0); PG8_MMA(0, 1, At, B1); PG8_BAR;
            PG8_LDA(At, 1, 1); PG8_STAGE(PG8_SA(1, 0), a3, voffA);
            PG8_BAR; PG8_WAIT_L(0); PG8_MMA(1, 0, At, B0); PG8_BAR; PG8_SCHED;
            PG8_STAGE(PG8_SB(1, 1), b3 + hstep, voffB);
            PG8_WAIT_V(6); PG8_BAR; PG8_MMA(1, 1, At, B1); PG8_BAR;
            }
        }
        if constexpr (ALIGN_EPI) { if (wr == 0) PG8_BAR; }
        if constexpr (!Epi::AFTER_DRAIN) { E(acc, cur, wr, wc, fr, fq); S.done(cur); }
        if (!has_next) break;
#pragma unroll
        for (int a = 0; a < 2; ++a)
#pragma unroll
            for (int b = 0; b < 2; ++b)
#pragma unroll
                for (int m = 0; m < 4; ++m)
#pragma unroll
                    for (int n = 0; n < 2; ++n) acc[a][b][m][n] = (f32x4){0.f, 0.f, 0.f, 0.f};
        cur = nxt; cA = nA; cB = nB; ++ui;
        if constexpr (ALIGN_EPI) { if (wr == 1) PG8_BAR; }
    }
    PG8_WAIT_V(0);
    if constexpr (!ALIGN_EPI) { if (wr == 0) PG8_BAR; }
    PG8_BAR;
    if constexpr (Epi::AFTER_DRAIN) { E.fused(acc, cur, wr, wc, fr, fq, lds, wid, lane); S.done(cur); }
#undef PG8_SA
#undef PG8_SB
#undef PG8_STAGE
#undef PG8_LDA
#undef PG8_LDB
#undef PG8_MMA
#undef PG8_WAIT_V
#undef PG8_WAIT_L
#undef PG8_BAR
#undef PG8_SCHED
}
}
namespace sba {
using bf16x8 = __attribute__((ext_vector_type(8))) short;
using s16x4 = __attribute__((ext_vector_type(4))) short;
using f32x16 = __attribute__((ext_vector_type(16))) float;
using u32x4 = __attribute__((ext_vector_type(4))) unsigned;
typedef unsigned short bf16;
constexpr int DM = 1024, KVBLK = 64, QBLK = 32, QB = 256, SLOTB = 8192;
constexpr int LDS_K = 0, LDS_V = 2 * SLOTB, LDS_OST = 4 * SLOTB, LDS_BYTES = LDS_OST + 8 * 4096;
__device__ __forceinline__ int crow(int r, int hi) { return (r & 3) + 8 * (r >> 2) + 4 * hi; }
__device__ __forceinline__ void glds16(const void* gsrc, unsigned lds_dst) { unsigned keep;
    asm volatile("s_mov_b32 %0, m0\n\ts_mov_b32 m0, %2\n\ts_nop 0\n\tglobal_load_lds_dwordx4 %1, off\n\ts_mov_b32 m0, %0" : "=&s"(keep) : "v"(gsrc), "s"(lds_dst) : "memory"); }
typedef float f32x2_t __attribute__((ext_vector_type(2))); typedef __bf16 bf16x2_t __attribute__((ext_vector_type(2)));
__device__ __forceinline__ unsigned cvtpk_s(float lo, float hi) { f32x2_t v = {lo, hi}; bf16x2_t b = __builtin_convertvector(v, bf16x2_t); return __builtin_bit_cast(unsigned, b); }
#define SBA_WAIT_BAR() asm volatile("s_waitcnt vmcnt(0) lgkmcnt(0)\n\ts_barrier" ::: "memory")
typedef __attribute__((address_space(3))) const char* lds_cptr;

__device__ __forceinline__ void qkt(f32x16& p0, f32x16& p1, lds_cptr Kslot, const bf16x8* qr, int r32, int hi) {
    lds_cptr kb = Kslot + hi * 1024 + r32 * 16;
    const f32x16 z = f32x16{};
#pragma unroll
    for (int d0 = 0; d0 < 4; ++d0) {
        const bf16x8 b0 = *(const __attribute__((address_space(3))) bf16x8*)(kb + d0 * 2048);
        const bf16x8 b1 = *(const __attribute__((address_space(3))) bf16x8*)(kb + d0 * 2048 + 512);
        if (d0 == 0) { p0 = __builtin_amdgcn_mfma_f32_32x32x16_bf16(b0, qr[0], z, 0, 0, 0); p1 = __builtin_amdgcn_mfma_f32_32x32x16_bf16(b1, qr[0], z, 0, 0, 0); }
        else { p0 = __builtin_amdgcn_mfma_f32_32x32x16_bf16(b0, qr[d0], p0, 0, 0, 0); p1 = __builtin_amdgcn_mfma_f32_32x32x16_bf16(b1, qr[d0], p1, 0, 0, 0); } }
}
__device__ __forceinline__ void pv(f32x16* o, int vb, bf16x8 pa0, bf16x8 pa1, bf16x8 pa2, bf16x8 pa3) {
#pragma unroll
    for (int d0 = 0; d0 < 2; ++d0) { s16x4 lo[4], hi[4];
#pragma unroll
        for (int ks = 0; ks < 4; ++ks) {
            asm volatile("ds_read_b64_tr_b16 %0,%1 offset:%c2" : "=&v"(lo[ks]) : "v"(vb), "i"(d0 * 4096 + ks * 1024) : "memory");
            asm volatile("ds_read_b64_tr_b16 %0,%1 offset:%c2" : "=&v"(hi[ks]) : "v"(vb), "i"(d0 * 4096 + ks * 1024 + 512) : "memory"); }
        asm volatile("s_waitcnt lgkmcnt(0)" ::: "memory"); __builtin_amdgcn_sched_barrier(0);
#define SBA_PK(k) (bf16x8){lo[k][0], lo[k][1], lo[k][2], lo[k][3], hi[k][0], hi[k][1], hi[k][2], hi[k][3]}
        o[d0] = __builtin_amdgcn_mfma_f32_32x32x16_bf16(pa0, SBA_PK(0), o[d0], 0, 0, 0);
        o[d0] = __builtin_amdgcn_mfma_f32_32x32x16_bf16(pa1, SBA_PK(1), o[d0], 0, 0, 0);
        o[d0] = __builtin_amdgcn_mfma_f32_32x32x16_bf16(pa2, SBA_PK(2), o[d0], 0, 0, 0);
        o[d0] = __builtin_amdgcn_mfma_f32_32x32x16_bf16(pa3, SBA_PK(3), o[d0], 0, 0, 0);
#undef SBA_PK
    }
}

__device__ __forceinline__ void sb_weights(f32x16& p0, f32x16& p1, float& carry, int hi, int qk, bool diag) {
    f32x16 k0v, k1v;
#pragma unroll
    for (int r = 0; r < 16; ++r) {
        const float e0 = __builtin_amdgcn_exp2f(__builtin_fminf(p0[r], 64.f)), e1 = __builtin_amdgcn_exp2f(__builtin_fminf(p1[r], 64.f));
        float kp0 = __builtin_amdgcn_rcpf(1.0f + e0), kp1 = __builtin_amdgcn_rcpf(1.0f + e1);
        float sg0 = e0 * kp0, sg1 = e1 * kp1;
        if (diag) { const int kk = crow(r, hi); if (kk >= qk) { kp0 = 1.f; sg0 = 0.f; } if (kk + 32 >= qk) { kp1 = 1.f; sg1 = 0.f; } }
        k0v[r] = kp0; k1v[r] = kp1; p0[r] = sg0; p1[r] = sg1;
    }
    float R = carry;
#define SBA_GROUP(P, KV, g) do { \
        const float q2 = KV[4 * (g) + 3], q1 = q2 * KV[4 * (g) + 2], q0 = q1 * KV[4 * (g) + 1], gp = q0 * KV[4 * (g)]; \
        const unsigned own = __float_as_uint(gp); auto rr = __builtin_amdgcn_permlane32_swap(own, own, false, false); \
        const float other = __uint_as_float(rr[0] ^ rr[1] ^ own), pairp = __uint_as_float(rr[0]) * __uint_as_float(rr[1]); \
        const float rin = hi ? R : R * other; \
        P[4 * (g) + 3] *= rin; P[4 * (g) + 2] *= rin * q2; P[4 * (g) + 1] *= rin * q1; P[4 * (g)] *= rin * q0; \
        R *= pairp; } while (0)
    SBA_GROUP(p1, k1v, 3); SBA_GROUP(p1, k1v, 2); SBA_GROUP(p1, k1v, 1); SBA_GROUP(p1, k1v, 0);
    SBA_GROUP(p0, k0v, 3); SBA_GROUP(p0, k0v, 2); SBA_GROUP(p0, k0v, 1); SBA_GROUP(p0, k0v, 0);
#undef SBA_GROUP
    carry = R;
}

__device__ __forceinline__ void attn_unit(int b, int h, int qb, const bf16* Q, const bf16* K, const bf16* V, bf16* O, __attribute__((address_space(3))) char* shm) {
    const int tid = opaque_tid(), lane = tid & 63, r32 = lane & 31, hi = lane >> 5; const int wid = __builtin_amdgcn_readfirstlane(tid >> 6);
    const long rowbase = (long)b * SEQ; const int q0 = qb * QB;
    const bf16* Qw = Q + (rowbase + q0 + wid * QBLK) * DM + h * HD;
    const bf16* Kh = K + rowbase * DM + h * HD, * Vh = V + rowbase * DM + h * HD;
    const unsigned lds0 = (unsigned)(uintptr_t)shm;
    const bf16* ksrc = Kh + (long)lane * DM + wid * 8;
    const bf16* vsrc = Vh + (long)(16 * (wid & 3) + (lane >> 2)) * DM + (wid >> 2) * 32 + (lane & 3) * 8;
    const unsigned kdst = lds0 + LDS_K + wid * 1024, vdst = lds0 + LDS_V + wid * 1024;
#define SBA_DMA_K(t, slot) glds16(ksrc + (long)(t) * KVBLK * DM, (unsigned)__builtin_amdgcn_readfirstlane(kdst + (slot)))
#define SBA_DMA_V(t, slot) glds16(vsrc + (long)(t) * KVBLK * DM, (unsigned)__builtin_amdgcn_readfirstlane(vdst + (slot)))
    const int vb0 = (int)(lds0 + LDS_V) + ((lane >> 4) & 1) * 32 + (lane & 3) * 8 + (4 * hi + ((lane & 15) >> 2)) * 64;
    const lds_cptr shm3 = (lds_cptr)shm;
    const int NT = (q0 + QB) / KVBLK;
    SBA_DMA_K(NT - 1, 0); SBA_DMA_V(NT - 1, 0);
    bf16x8 qr[4];
#pragma unroll
    for (int d0 = 0; d0 < 4; ++d0) qr[d0] = *reinterpret_cast<const bf16x8*>(&Qw[(long)r32 * DM + d0 * 16 + hi * 8]);
    f32x16 o[2]; o[0] = f32x16{}; o[1] = f32x16{};
    float carry = 1.0f;
    const int qw0 = q0 + wid * QBLK;
    int slot = 0;
    for (int t = NT - 1; t >= 0; --t) {
        SBA_WAIT_BAR();
        if (t > 0) { SBA_DMA_K(t - 1, slot ^ SLOTB); SBA_DMA_V(t - 1, slot ^ SLOTB); }
        if (64 * t <= qw0) {
            f32x16 p0, p1;
            qkt(p0, p1, shm3 + LDS_K + slot, qr, r32, hi);
            sb_weights(p0, p1, carry, hi, qw0 + r32 - 64 * t, 64 * t + 64 > qw0);
            u32x4 pw0, pw1, pw2, pw3;
            pw0 = (u32x4){cvtpk_s(p0[0], p0[1]), cvtpk_s(p0[2], p0[3]), cvtpk_s(p0[4], p0[5]), cvtpk_s(p0[6], p0[7])};
            pw1 = (u32x4){cvtpk_s(p0[8], p0[9]), cvtpk_s(p0[10], p0[11]), cvtpk_s(p0[12], p0[13]), cvtpk_s(p0[14], p0[15])};
            pw2 = (u32x4){cvtpk_s(p1[0], p1[1]), cvtpk_s(p1[2], p1[3]), cvtpk_s(p1[4], p1[5]), cvtpk_s(p1[6], p1[7])};
            pw3 = (u32x4){cvtpk_s(p1[8], p1[9]), cvtpk_s(p1[10], p1[11]), cvtpk_s(p1[12], p1[13]), cvtpk_s(p1[14], p1[15])};
            __builtin_amdgcn_sched_barrier(0);
            pv(o, vb0 + slot, __builtin_bit_cast(bf16x8, pw0), __builtin_bit_cast(bf16x8, pw1), __builtin_bit_cast(bf16x8, pw2), __builtin_bit_cast(bf16x8, pw3));
        }
        slot ^= SLOTB;
    }
    bf16* Ow = O + (rowbase + q0 + wid * QBLK) * DM + h * HD;
    { __attribute__((address_space(3))) bf16* stg = (__attribute__((address_space(3))) bf16*)(shm3 + LDS_OST) + wid * 2048;
#pragma unroll
      for (int r = 0; r < 16; ++r) { const int orow = crow(r, hi);
#pragma unroll
        for (int d0 = 0; d0 < 2; ++d0) { const unsigned pk = cvtpk_s(o[d0][r], 0.f); stg[orow * 64 + d0 * 32 + r32] = (bf16)(pk & 0xffffu); } }
      asm volatile("s_waitcnt lgkmcnt(0)" ::: "memory");
#pragma unroll
      for (int i = 0; i < 4; ++i) { const int row = i * 8 + (lane >> 3), ch = lane & 7; const u32x4 v = *(const __attribute__((address_space(3))) u32x4*)(stg + row * 64 + ch * 8); *(u32x4*)(Ow + (long)row * DM + ch * 8) = v; } }
    asm volatile("s_waitcnt lgkmcnt(0)\n\ts_barrier" ::: "memory");
#undef SBA_DMA_K
#undef SBA_DMA_V
}
#undef SBA_WAIT_BAR
}

#define GAS __attribute__((address_space(1)))
#define LAS __attribute__((address_space(3)))
typedef unsigned short bf16;
typedef unsigned v4u __attribute__((ext_vector_type(4)));
typedef unsigned v2u __attribute__((ext_vector_type(2)));
typedef float f32x4 __attribute__((ext_vector_type(4)));
typedef short bf16x8 __attribute__((ext_vector_type(8)));
typedef GAS unsigned gu32;
#define RLX_AGENT __ATOMIC_RELAXED, __HIP_MEMORY_SCOPE_AGENT
#define LDS_WAIT() asm volatile("s_waitcnt lgkmcnt(0)" ::: "memory")
#define VM_WAIT() asm volatile("s_waitcnt vmcnt(0)" ::: "memory")
constexpr int NWAVES = 8;

constexpr size_t MiB = 1u << 20;
constexpr size_t WS_CTL = 0, CTL_ZERO_BYTES = 1 * MiB;
constexpr size_t WS_MOD = 1 * MiB;
constexpr size_t WS_SA = 2 * MiB, WS_SB = 3 * MiB;
constexpr size_t WS_WGU = 4 * MiB;
constexpr size_t WS_WDN = 48 * MiB;
constexpr size_t WS_WQKV = 70 * MiB, WS_WO = 76 * MiB, WS_WIN = 78 * MiB, WS_WOUT = 83 * MiB, WS_WRI = 86 * MiB;
constexpr size_t WS_XN = 88 * MiB;
constexpr size_t WS_OV = 120 * MiB;
constexpr size_t WS_ACT = WS_OV, WS_QO = WS_OV, WS_K = WS_OV + 32 * MiB, WS_V = WS_OV + 64 * MiB, WS_GG = WS_OV, WS_XB = WS_OV + 40 * MiB;
constexpr size_t WS_END = 240 * MiB;
constexpr size_t WS_SCR = 256 * MiB, WS_SCR_END = 320 * MiB;
static_assert(WS_WGU + 4 * (size_t)NGU * D * 2 <= WS_WDN && WS_WDN + 4 * (size_t)D * FF * 2 <= WS_WQKV && WS_WQKV + (size_t)NQKV * D * 2 <= WS_WO && WS_WO + (size_t)D * D * 2 <= WS_WIN &&
              WS_WIN + (size_t)NIN * D * 2 <= WS_WOUT && WS_WOUT + (size_t)D * DR * 2 <= WS_WRI && WS_WRI + 10 * 256 * 128 * 2 <= WS_XN && WS_XN + (size_t)M * D * 2 <= WS_OV &&
              WS_ACT + (size_t)M * FF * 2 <= WS_END && WS_V + (size_t)M * D * 2 <= WS_END && WS_XB + (size_t)M * DR * 4 <= WS_END && WS_GG + (size_t)M * DR * 2 <= WS_XB, "d_ws map");
constexpr int CW_BAR = 4096;

constexpr int RING_OFF = 0, RING_BYTES = 131072;
constexpr int LDS_BYTES = 155648;
constexpr int MISC_OFF = LDS_BYTES - 256;

__device__ __forceinline__ unsigned f2bf(float f) { unsigned u = __builtin_bit_cast(unsigned, f); return (u + 0x7fffu + ((u >> 16) & 1u)) >> 16; }
__device__ __forceinline__ unsigned pk2(float lo, float hi) { return f2bf(lo) | (f2bf(hi) << 16); }
__device__ __forceinline__ float bf2f(unsigned short b) { return __builtin_bit_cast(float, (unsigned)b << 16); }

#define XB_TMO      128
#define XB_XCNT(j)  (256  + 64 * (j))
#define XB_XSUB(j)  (1280 + 64 * (j))
#define XB_XGEN(j)  (2304 + 64 * (j))
#define XB_TOP      3328
#define XB_TOPGEN   3392
#define XCD_BAR_WORDS 3456
#define XB_SPIN_CAP (1u << 18)
__device__ __forceinline__ unsigned xb_ld(unsigned* p)              { return __hip_atomic_load(p, __ATOMIC_RELAXED, __HIP_MEMORY_SCOPE_AGENT); }
__device__ __forceinline__ unsigned xb_add(unsigned* p, unsigned v) { return __hip_atomic_fetch_add(p, v, __ATOMIC_RELAXED, __HIP_MEMORY_SCOPE_AGENT); }
__device__ __forceinline__ unsigned xb_xcc_id() { return (unsigned)__builtin_amdgcn_s_getreg((3 << 11) | 20) & 0xFu; }
#define XB_SPIN(cond, bar) do { unsigned _sp = 0; while (cond) { __builtin_amdgcn_s_sleep(1); \
    if ((++_sp & 255u) == 0u) { if (xb_ld(&(bar)[XB_TMO])) break; if (_sp > XB_SPIN_CAP) { atomicAdd(&(bar)[XB_TMO], 1u); break; } } } } while (0)
struct XcdBarrier { unsigned* bar; unsigned x; volatile LAS unsigned* st; };
__device__ __forceinline__ XcdBarrier xcd_barrier_post(unsigned* bar, volatile LAS unsigned* st) {
    XcdBarrier b; b.bar = bar; b.x = xb_xcc_id(); b.st = st;
    if (threadIdx.x == 0) (void)xb_add(&bar[XB_XCNT(b.x)], 1u);
    return b;
}
__device__ __forceinline__ void xcd_barrier_complete(unsigned* bar, unsigned x, unsigned& nloc, unsigned& nx) {
    const unsigned G = gridDim.x * gridDim.y * gridDim.z;
    unsigned sum, cnt, mine, sp = 0u;
    for (;;) {
        sum = 0u; cnt = 0u; mine = 0u;
#pragma unroll
        for (unsigned j = 0; j < 16; ++j) { const unsigned c = xb_ld(&bar[XB_XCNT(j)]); sum += c; cnt += (c > 0u) ? 1u : 0u; mine = (j == x) ? c : mine; }
        if (sum == G) break;
        __builtin_amdgcn_s_sleep(1);
        if ((++sp & 255u) == 0u) { if (xb_ld(&bar[XB_TMO])) break; if (sp > XB_SPIN_CAP) { atomicAdd(&bar[XB_TMO], 1u); break; } }
    }
    nloc = mine > 0u ? mine : 1u; nx = cnt > 0u ? cnt : 1u;
}
__device__ __forceinline__ void xcd_barrier(const XcdBarrier& b) {
    asm volatile("s_waitcnt vmcnt(0)" ::: "memory");
    __syncthreads();
    if (threadIdx.x == 0) {
        GAS unsigned* barg = (GAS unsigned*)b.bar; asm volatile("" : "+s"(barg)); unsigned* bar = (unsigned*)barg;
        __builtin_amdgcn_s_waitcnt(0);
        unsigned nloc = b.st[0], nx = b.st[1];
        if (nloc == 0u) { xcd_barrier_complete(bar, b.x, nloc, nx); b.st[0] = nloc; b.st[1] = nx; }
        const unsigned old = xb_add(&bar[XB_XSUB(b.x)], 1u);
        const unsigned gen = old / nloc;
        if (old + 1u == (gen + 1u) * nloc) {
            __builtin_amdgcn_fence(__ATOMIC_RELEASE, "agent");
            asm volatile("s_waitcnt vmcnt(0)" ::: "memory");
            const unsigned og = xb_add(&bar[XB_TOP], 1u);
            const unsigned tg = og / nx;
            if (og + 1u == (tg + 1u) * nx) xb_add(&bar[XB_TOPGEN], 1u);
            else XB_SPIN(xb_ld(&bar[XB_TOPGEN]) == tg, bar);
            __builtin_amdgcn_fence(__ATOMIC_ACQUIRE, "agent");
            xb_add(&bar[XB_XGEN(b.x)], 1u);
            asm volatile("s_waitcnt vmcnt(0)" ::: "memory");
        } else {
            XB_SPIN(xb_ld(&bar[XB_XGEN(b.x)]) == gen, bar);
            __builtin_amdgcn_fence(__ATOMIC_ACQUIRE, "agent");
            asm volatile("s_waitcnt vmcnt(0)" ::: "memory");
        }
    }
    __syncthreads();
}

struct Args { const float* in[19]; float* out; unsigned char* ws; int ph_lo, ph_hi, use_bar, dup; };

__device__ __forceinline__ float wave_sum(float v) {
#pragma unroll
    for (int o = 1; o < 64; o <<= 1) v += __shfl_xor(v, o);
    return v;
}

__device__ __forceinline__ void tr_tile(const float* src, int lds_, bf16* dst, int ldd, LAS float* scr, int lane) {
#pragma unroll 8
    for (int i = 0; i < 32; ++i) { const int kk = 2 * i + (lane >> 5); scr[kk * 33 + (lane & 31)] = src[(size_t)kk * lds_ + (lane & 31)]; }
    LDS_WAIT(); asm volatile("" ::: "memory");
    const int c = lane & 7;
#pragma unroll
    for (int j = 0; j < 4; ++j) { const int n = (lane >> 3) + 8 * j; const LAS float* s = scr + (8 * c) * 33 + n;
        v4u o; o.x = pk2(s[0 * 33], s[1 * 33]); o.y = pk2(s[2 * 33], s[3 * 33]); o.z = pk2(s[4 * 33], s[5 * 33]); o.w = pk2(s[6 * 33], s[7 * 33]);
        *(GAS v4u*)(dst + (size_t)n * ldd + 8 * c) = o; }
    LDS_WAIT(); asm volatile("" ::: "memory");
}
__device__ __forceinline__ void tr_plain(const float* W, int K, int N, bf16* WT, LAS float* scr, int item, int lane) {
    const int nblk = N / 32, kb = item / nblk, nb = item % nblk, k0 = 64 * kb, n0 = 32 * nb;
    tr_tile(W + (size_t)k0 * N + n0, N, WT + (size_t)n0 * K + k0, K, scr, lane);
}
__device__ __forceinline__ void p0_prologue(const Args& a, unsigned char* ws, LAS unsigned char* lds, int vcu, int G, int tid, int lane, int wave) {
    LAS float* scr = (LAS float*)(lds + wave * 8448);
    const int gw = vcu * NWAVES + wave, NGW = G * NWAVES;
    constexpr int I_GU = (D / 64) * (NGU / 32), I_DN = (FF / 64) * (D / 32), I_QKV = (D / 64) * (NQKV / 32), I_O = (D / 64) * (D / 32), I_IN = (D / 64) * (NIN / 32), I_OUT = (DR / 64) * (D / 32), I_G = 2 * 4;
    constexpr int NITEMS = 4 * I_GU + 4 * I_DN + I_QKV + I_O + I_IN + I_OUT + 20 * I_G;
    for (int it = gw; it < NITEMS; it += NGW) {
        int r = it;
        if (r < 4 * I_GU) {
            const int mat = r / I_GU, item = r % I_GU; const int nblk = NGU / 32, kb = item / nblk, nb = item % nblk, k0 = 64 * kb, n0 = 32 * nb;
            const int isu = n0 >= FF ? 1 : 0, ff0 = n0 - isu * FF, L0 = (ff0 >> 7) * 256 + isu * 128 + (ff0 & 127);
            const float* W = a.in[5] + (size_t)mat * D * NGU; bf16* WT = (bf16*)(ws + WS_WGU) + (size_t)mat * NGU * D;
            tr_tile(W + (size_t)k0 * NGU + n0, NGU, WT + (size_t)L0 * D + k0, D, scr, lane); continue; }
        r -= 4 * I_GU;
        if (r < 4 * I_DN) { const int mat = r / I_DN; tr_plain(a.in[6] + (size_t)mat * FF * D, FF, D, (bf16*)(ws + WS_WDN) + (size_t)mat * D * FF, scr, r % I_DN, lane); continue; }
        r -= 4 * I_DN;
        if (r < I_QKV) { tr_plain(a.in[7], D, NQKV, (bf16*)(ws + WS_WQKV), scr, r, lane); continue; } r -= I_QKV;
        if (r < I_O) { tr_plain(a.in[8], D, D, (bf16*)(ws + WS_WO), scr, r, lane); continue; } r -= I_O;
        if (r < I_IN) { tr_plain(a.in[9], D, NIN, (bf16*)(ws + WS_WIN), scr, r, lane); continue; } r -= I_IN;
        if (r < I_OUT) { tr_plain(a.in[17], DR, D, (bf16*)(ws + WS_WOUT), scr, r, lane); continue; } r -= I_OUT;
        { const int mat = r / I_G, item = r % I_G, n = mat >> 1, isi = mat & 1;
          tr_plain((isi ? a.in[14] : a.in[12]) + (size_t)n * 128 * 128, 128, 128, (bf16*)(ws + WS_WRI) + (size_t)n * 256 * 128 + (size_t)isi * 128 * 128, scr, item, lane); }
    }
    __syncthreads();
    LAS float* ca = (LAS float*)lds;
    LAS float* part = (LAS float*)(lds + 32768);
    for (int i = tid; i < BATCH * D; i += NWAVES * 64) { const int b = i / D, k = i % D; const float c = a.in[1][i]; ca[k * 8 + b] = c * __builtin_amdgcn_rcpf(1.0f + __builtin_amdgcn_exp2f(-c * LOG2E)); }
    __syncthreads();
    float* MOD = (float*)(ws + WS_MOD);
    for (int ch = vcu; ch < 2 * NMOD / 72; ch += G) {
        const int g0 = ch * 72, l = g0 / NMOD, j0 = g0 % NMOD;
        const float* W = a.in[2] + (size_t)l * D * NMOD + j0;
        const int rs = lane / 18, cg = lane % 18;
        f32x4 acc[8];
#pragma unroll
        for (int b = 0; b < 8; ++b) acc[b] = (f32x4){0.f, 0.f, 0.f, 0.f};
        if (rs < 3) {
#pragma unroll 4
            for (int i = 0; i < 43; ++i) { const int kl = 3 * i + rs; if (kl < 128) { const int k = wave * 128 + kl;
                const f32x4 w = *(const f32x4*)(W + (size_t)k * NMOD + 4 * cg);
                const f32x4 c0 = *(const LAS f32x4*)(ca + k * 8), c1 = *(const LAS f32x4*)(ca + k * 8 + 4);
                acc[0] += w * c0[0]; acc[1] += w * c0[1]; acc[2] += w * c0[2]; acc[3] += w * c0[3]; acc[4] += w * c1[0]; acc[5] += w * c1[1]; acc[6] += w * c1[2]; acc[7] += w * c1[3]; } }
#pragma unroll
            for (int b = 0; b < 8; ++b) *(LAS f32x4*)(part + ((wave * 3 + rs) * 8 + b) * 72 + 4 * cg) = acc[b];
        }
        __syncthreads();
        for (int o = tid; o < 8 * 72; o += NWAVES * 64) { const int b = o / 72, j = o % 72; float s = a.in[3][(size_t)l * NMOD + j0 + j];
#pragma unroll
            for (int p = 0; p < 24; ++p) s += part[(p * 8 + b) * 72 + j];
            MOD[((size_t)l * BATCH + b) * NMOD + j0 + j] = s; }
        __syncthreads();
    }
}

__device__ __forceinline__ void norm_mod_phase(const float* x, const float* g, const float* shift, const float* scale, bf16* XN, int vcu, int G, int lane, int wave) {
    const int gw = vcu * NWAVES + wave, NGW = G * NWAVES;
    for (int blk = gw; blk < M / 8; blk += NGW) {
        const int row0 = blk * 8, b = row0 / SEQ;
        f32x4 gs[4], sh[4];
#pragma unroll
        for (int j = 0; j < 4; ++j) { const int c = 4 * lane + 256 * j; gs[j] = *(const f32x4*)(g + c) * (*(const f32x4*)(scale + (size_t)b * NMOD + c) + 1.0f); sh[j] = *(const f32x4*)(shift + (size_t)b * NMOD + c); }
#pragma unroll 2
        for (int r = 0; r < 8; ++r) {
            const f32x4* xr = (const f32x4*)(x + (size_t)(row0 + r) * D) + lane;
            f32x4 v[4]; float s = 0.f;
#pragma unroll
            for (int j = 0; j < 4; ++j) { v[j] = xr[64 * j]; s += (v[j].x * v[j].x + v[j].y * v[j].y) + (v[j].z * v[j].z + v[j].w * v[j].w); }
            const float inv = 1.0f / sqrtf(wave_sum(s) * (1.f / D) + RMS_EPS);
            v2u* o8 = (v2u*)(XN + (size_t)(row0 + r) * D) + lane;
#pragma unroll
            for (int j = 0; j < 4; ++j) { const f32x4 h = v[j] * inv * gs[j] + sh[j]; v2u w; w.x = pk2(h.x, h.y); w.y = pk2(h.z, h.w); o8[64 * j] = w; }
        }
    }
}
__device__ __forceinline__ void final_norm_phase(const float* x, const float* g, float* out, int vcu, int G, int lane, int wave) {
    const int gw = vcu * NWAVES + wave, NGW = G * NWAVES;
    f32x4 gs[4];
#pragma unroll
    for (int j = 0; j < 4; ++j) gs[j] = *(const f32x4*)(g + 4 * lane + 256 * j);
    for (int row = gw; row < M; row += NGW) {
        const f32x4* xr = (const f32x4*)(x + (size_t)row * D) + lane;
        f32x4 v[4]; float s = 0.f;
#pragma unroll
        for (int j = 0; j < 4; ++j) { v[j] = xr[64 * j]; s += (v[j].x * v[j].x + v[j].y * v[j].y) + (v[j].z * v[j].z + v[j].w * v[j].w); }
        const float inv = 1.0f / sqrtf(wave_sum(s) * (1.f / D) + RMS_EPS);
        f32x4* o = (f32x4*)(out + (size_t)row * D) + lane;
#pragma unroll
        for (int j = 0; j < 4; ++j) o[64 * j] = v[j] * inv * gs[j];
    }
}

namespace lru {
constexpr int WSTR = 272;
constexpr int OFF_W = 0;
constexpr int OFF_XT = OFF_W + 256 * WSTR;
constexpr int OFF_AT = OFF_XT + 35 * 512;
constexpr int OFF_XC = OFF_AT + 32 * WSTR;
constexpr int OFF_A = OFF_XC + 32 * 512;
constexpr int OFF_B = OFF_A + 32 * 512;
constexpr int OFF_P = OFF_B + 32 * 512;
constexpr int LDS_END = OFF_P + 8 * 512;
static_assert(LDS_END <= MISC_OFF, "lru LDS map");
#define LRU_SYNC() asm volatile("s_waitcnt lgkmcnt(0)\n\ts_barrier" ::: "memory")

template <int PASS> __device__ __forceinline__ void lru_pass(const Args& a, unsigned char* ws, bf16* Yout, LAS unsigned char* lds, int id0, int id1, int tid, int lane, int wave) {
    const float* XB = (const float*)(ws + WS_XB); const bf16* GG = (const bf16*)(ws + WS_GG); float* SA = (float*)(ws + WS_SA); float* SB = (float*)(ws + WS_SB);
    LAS float* XT = (LAS float*)(lds + OFF_XT); LAS float* XC = (LAS float*)(lds + OFF_XC); LAS float* Aa = (LAS float*)(lds + OFF_A); LAS float* Bb = (LAS float*)(lds + OFF_B); LAS float* P = (LAS float*)(lds + OFF_P);
    const int yrow = tid >> 4, yc8 = (tid & 15) * 8;
#define LRU_LOADX(dst, id_, sub_) do { const int idt = (id_); if (idt < id1) { const int nt = idt >> 7, ct = idt & 127, s0t = (ct >> 4) * SEQ, r0t = ct * 128 + 32 * (sub_); \
        _Pragma("unroll") for (int q = 0; q < 3; ++q) { const int i = tid + 512 * q; dst[q] = (f32x4){0.f, 0.f, 0.f, 0.f}; \
            if (i < 35 * 32) { const int grow = r0t - 3 + (i >> 5); if (grow >= s0t) dst[q] = *(const f32x4*)(XB + (size_t)grow * DR + nt * 128 + 4 * (i & 31)); } } } } while (0)
#define LRU_STOREX(src) do { _Pragma("unroll") for (int q = 0; q < 3; ++q) { const int i = tid + 512 * q; if (i < 35 * 32) *(LAS f32x4*)(XT + (i >> 5) * 128 + 4 * (i & 31)) = src[q]; } } while (0)
#define LRU_LOADG(dst, id_, sub_) do { const int idt = (id_); if (PASS == 2 && idt < id1) { const int nt = idt >> 7, ct = idt & 127; dst = *(const v4u*)(GG + (size_t)(ct * 128 + 32 * (sub_) + yrow) * DR + nt * 128 + yc8); } } while (0)
    f32x4 xr[4][3]; v4u gr[4];
#pragma unroll
    for (int s = 0; s < 4; ++s) { gr[s] = (v4u){0u, 0u, 0u, 0u};
#pragma unroll
        for (int q = 0; q < 3; ++q) xr[s][q] = (f32x4){0.f, 0.f, 0.f, 0.f}; }
    if (id0 >= id1) return;
#pragma unroll
    for (int s = 0; s < 4; ++s) { LRU_LOADX(xr[s], id0, s); LRU_LOADG(gr[s], id0, s); }
    LRU_STOREX(xr[0]); LRU_LOADX(xr[0], id0 + 1, 0);
    int ncur = -1; float h = 0.f, Ac = 1.f;
    for (int id = id0; id < id1; ++id) {
        const int n = id >> 7, chunk = id & 127;
        if (n != ncur) {
            const bf16* Wg = (const bf16*)(ws + WS_WRI) + (size_t)n * 256 * 128;
            for (int i = tid; i < 256 * 16; i += NWAVES * 64) { const int row = i >> 4, c16 = i & 15; *(LAS v4u*)(lds + OFF_W + row * WSTR + c16 * 16) = *(const v4u*)(Wg + row * 128 + c16 * 8); }
            if (tid < 128) { const int ch = n * 128 + tid;
                P[0 * 128 + tid] = a.in[10][0 * DR + ch]; P[1 * 128 + tid] = a.in[10][1 * DR + ch]; P[2 * 128 + tid] = a.in[10][2 * DR + ch]; P[3 * 128 + tid] = a.in[10][3 * DR + ch];
                P[4 * 128 + tid] = a.in[11][ch]; P[5 * 128 + tid] = a.in[13][ch] * LOG2E; P[6 * 128 + tid] = a.in[15][ch] * LOG2E; P[7 * 128 + tid] = 8.0f * log1pf(expf(-a.in[16][ch])); }
        }
        if (PASS == 1) { h = 0.f; Ac = 1.f; }
        else if (tid < 128) { const int cs = chunk & 15, c0 = chunk - cs;
            if (cs == 0) h = 0.f;
            else if (id == id0 || n != ncur) {
                float sa[15], sb[15];
#pragma unroll
                for (int c = 0; c < 15; ++c) { const size_t idx = (size_t)(c0 + (c < cs ? c : 0)) * DR + n * 128 + tid; sa[c] = SA[idx]; sb[c] = SB[idx]; }
                h = 0.f;
#pragma unroll
                for (int c = 0; c < 15; ++c) if (c < cs) h = sa[c] * h + sb[c];
            } }
        ncur = n;
        LRU_SYNC();
#pragma unroll
        for (int sub = 0; sub < 4; ++sub) {
            const int r0 = chunk * 128 + sub * 32;
            { const int row = tid >> 4, c8 = (tid & 15) * 8; float xc[8];
#pragma unroll
              for (int e = 0; e < 8; ++e) { const int ch = c8 + e; float s = P[4 * 128 + ch];
#pragma unroll
                  for (int tap = 0; tap < 4; ++tap) s += XT[(row + tap) * 128 + ch] * P[tap * 128 + ch];
                  xc[e] = s; }
              *(LAS f32x4*)(XC + row * 128 + c8) = (f32x4){xc[0], xc[1], xc[2], xc[3]}; *(LAS f32x4*)(XC + row * 128 + c8 + 4) = (f32x4){xc[4], xc[5], xc[6], xc[7]};
              v4u o; o.x = pk2(xc[0], xc[1]); o.y = pk2(xc[2], xc[3]); o.z = pk2(xc[4], xc[5]); o.w = pk2(xc[6], xc[7]);
              *(LAS v4u*)(lds + OFF_AT + row * WSTR + c8 * 2) = o; }
            LRU_SYNC();
            LRU_STOREX(xr[(sub + 1) & 3]); LRU_LOADX(xr[(sub + 1) & 3], id + 1 + (sub == 3 ? 1 : 0), (sub + 1) & 3);
            { const int rg = wave & 1, cq = wave >> 1, fr = lane & 15, fq = lane >> 4;
              f32x4 acc[4];
#pragma unroll
              for (int t = 0; t < 4; ++t) acc[t] = (f32x4){0.f, 0.f, 0.f, 0.f};
#pragma unroll
              for (int ks = 0; ks < 4; ++ks) { const bf16x8 af = *(const LAS bf16x8*)(lds + OFF_AT + (16 * rg + fr) * WSTR + (32 * ks + 8 * fq) * 2);
#pragma unroll
                  for (int t = 0; t < 4; ++t) { const int orow = (t >> 1) * 128 + 32 * cq + 16 * (t & 1) + fr; const bf16x8 bfg = *(const LAS bf16x8*)(lds + OFF_W + orow * WSTR + (32 * ks + 8 * fq) * 2);
                      acc[t] = __builtin_amdgcn_mfma_f32_16x16x32_bf16(bfg, af, acc[t], 0, 0, 0); } }
              const int row = 16 * rg + fr;
#pragma unroll
              for (int tt = 0; tt < 2; ++tt) { const int ch0 = 32 * cq + 16 * tt + 4 * fq;
                  const f32x4 br = *(const LAS f32x4*)(P + 5 * 128 + ch0), bi = *(const LAS f32x4*)(P + 6 * 128 + ch0), sp = *(const LAS f32x4*)(P + 7 * 128 + ch0), xcv = *(const LAS f32x4*)(XC + row * 128 + ch0);
                  f32x4 av, bv;
#pragma unroll
                  for (int e = 0; e < 4; ++e) {
                      const float r = __builtin_amdgcn_rcpf(1.0f + __builtin_amdgcn_exp2f(-(acc[tt][e] * LOG2E + br[e]))), ig = __builtin_amdgcn_rcpf(1.0f + __builtin_amdgcn_exp2f(-(acc[2 + tt][e] * LOG2E + bi[e])));
                      const float la = -r * sp[e], aa = __builtin_amdgcn_exp2f(la * LOG2E), t = 2.0f * la;
                      const float em_small = -t * (1.0f + t * (0.5f + t * (0.16666667f + t * (0.041666668f + t * 0.0083333338f)))), em = (t > -0.25f) ? em_small : (1.0f - aa * aa);
                      av[e] = aa; bv[e] = __builtin_amdgcn_sqrtf(em) * (ig * xcv[e]); }
                  *(LAS f32x4*)(Aa + row * 128 + ch0) = av; *(LAS f32x4*)(Bb + row * 128 + ch0) = bv; } }
            LRU_SYNC();
            if (tid < 128) {
                float av[32], bv[32];
#pragma unroll
                for (int r = 0; r < 32; ++r) { av[r] = Aa[r * 128 + tid]; bv[r] = Bb[r * 128 + tid]; }
#pragma unroll
                for (int r = 0; r < 32; ++r) { h = av[r] * h + bv[r]; Ac *= av[r]; bv[r] = h; }
                if (PASS == 2) {
#pragma unroll
                    for (int r = 0; r < 32; ++r) Bb[r * 128 + tid] = bv[r]; } }
            if (PASS == 2) {
                LRU_SYNC();
                const LAS float* hp = Bb + yrow * 128 + yc8; const f32x4 h0 = *(const LAS f32x4*)hp, h1 = *(const LAS f32x4*)(hp + 4);
                const v4u g = gr[sub]; v4u o;
                o.x = pk2(bf2f((unsigned short)(g.x & 0xffffu)) * h0[0], bf2f((unsigned short)(g.x >> 16)) * h0[1]); o.y = pk2(bf2f((unsigned short)(g.y & 0xffffu)) * h0[2], bf2f((unsigned short)(g.y >> 16)) * h0[3]);
                o.z = pk2(bf2f((unsigned short)(g.z & 0xffffu)) * h1[0], bf2f((unsigned short)(g.z >> 16)) * h1[1]); o.w = pk2(bf2f((unsigned short)(g.w & 0xffffu)) * h1[2], bf2f((unsigned short)(g.w >> 16)) * h1[3]);
                *(v4u*)(Yout + (size_t)(r0 + yrow) * DR + n * 128 + yc8) = o;
                LRU_LOADG(gr[sub], id + 1, sub);
            }
        }
        if (PASS == 1 && tid < 128) { const size_t idx = (size_t)chunk * DR + n * 128 + tid; SA[idx] = Ac; SB[idx] = h; }
    }
    LRU_SYNC();
#undef LRU_LOADX
#undef LRU_STOREX
#undef LRU_LOADG
}
#undef LRU_SYNC
}

enum { PH_PROLOGUE = 0, PH_NORM, PH_GU, PH_DOWN, PH_QKV, PH_ATTN, PH_WO, PH_WIN, PH_LRU1, PH_LRU2, PH_WOUT, PH_FINAL };
constexpr int NPHASES = 23;
__constant__ int PH_KIND[NPHASES] = { PH_PROLOGUE,
    PH_NORM, PH_GU, PH_DOWN,  PH_NORM, PH_QKV, PH_ATTN, PH_WO,            PH_NORM, PH_GU, PH_DOWN,
    PH_NORM, PH_GU, PH_DOWN,  PH_NORM, PH_WIN, PH_LRU1, PH_LRU2, PH_WOUT, PH_NORM, PH_GU, PH_DOWN,
    PH_FINAL };
__constant__ int PH_LAYER[NPHASES] = { 0, 0,0,0, 0,0,0,0, 0,0,0, 1,1,1, 1,1,1,1,1, 1,1,1, 1 };
__constant__ int PH_SUB[NPHASES]   = { 0, 0,0,0, 1,1,1,1, 2,2,2, 0,0,0, 1,1,1,1,1, 2,2,2, 0 };

__global__ void __launch_bounds__(NWAVES * 64, 2) fwd_kernel(Args args) {
    extern __shared__ __attribute__((aligned(16))) unsigned char lds_raw[];
    LAS unsigned char* lds = (LAS unsigned char*)lds_raw;
    volatile LAS unsigned* MISC = (volatile LAS unsigned*)(lds + MISC_OFF);
    const int tid0 = threadIdx.x;
    const int G = gridDim.x; const int bx = blockIdx.x; const int vcu = (G % 8 == 0) ? (bx % 8) * (G / 8) + bx / 8 : bx;
    unsigned char* ws0 = args.ws;
    gu32* ctl = (gu32*)(ws0 + WS_CTL);
    for (int u = tid0; u < 64; u += NWAVES * 64) MISC[u] = 0u;
    __syncthreads();
    XcdBarrier bar; bar.bar = (unsigned*)(ctl + CW_BAR); bar.x = 0; bar.st = nullptr;
    if (args.use_bar) bar = xcd_barrier_post((unsigned*)(ctl + CW_BAR), MISC + 8);

    float* X = args.out;

    for (int ph = args.ph_lo; ph < args.ph_hi; ++ph) {
        const int kind = __builtin_amdgcn_readfirstlane(PH_KIND[ph]), l = __builtin_amdgcn_readfirstlane(PH_LAYER[ph]), sub = __builtin_amdgcn_readfirstlane(PH_SUB[ph]);
        const int reps = ((args.dup >> kind) & 1) ? 2 : 1;
        for (int rep = 0; rep < reps; ++rep) {
#define PHASE_LOCALS int tid = tid0; asm volatile("" : "+v"(tid)); GAS unsigned char* wsg = (GAS unsigned char*)ws0; asm volatile("" : "+s"(wsg)); unsigned char* ws = (unsigned char*)wsg; \
        const int lane = tid & 63, wave = __builtin_amdgcn_readfirstlane(tid >> 6); float* MOD = (float*)(ws + WS_MOD); bf16* XN = (bf16*)(ws + WS_XN); \
        const float* modl = MOD + (size_t)l * BATCH * NMOD + (size_t)sub * 3 * D; (void)lane; (void)wave; (void)XN; (void)modl; (void)tid;
        const int fidx = l * 2 + (sub == 2 ? 1 : 0);
        const bool dry = rep + 1 < reps;
        if (kind == PH_PROLOGUE) {
            PHASE_LOCALS
            p0_prologue(args, ws, lds, vcu, G, tid, lane, wave);
        } else if (kind == PH_NORM) {
            PHASE_LOCALS
            const float* xin = (ph == 1) ? args.in[0] : X;
            norm_mod_phase(xin, args.in[4] + (size_t)(l * 3 + sub) * D, modl, modl + D, XN, vcu, G, lane, wave);
        } else if (kind == PH_GU) {
            PHASE_LOCALS
            pg8::Gemm g{XN, (const bf16*)(ws + WS_WGU) + (size_t)fidx * NGU * D, M, NGU, D}; pg8::StaticOrder S; S.init(M, NGU, G, bx);
            pg8::EpiSwiglu E{(bf16*)(ws + WS_ACT), FF};
            pg8::gemm_phase<pg8::EpiSwiglu, pg8::StaticOrder, true, true>(lds + RING_OFF, g, S, E);
        } else if (kind == PH_DOWN || kind == PH_WO || kind == PH_WOUT) {
            PHASE_LOCALS
            const bf16* A; const bf16* Bt; int K; float mw;
            if (kind == PH_DOWN) { A = (const bf16*)(ws + WS_ACT); Bt = (const bf16*)(ws + WS_WDN) + (size_t)fidx * D * FF; K = FF; mw = 0.5f; }
            else if (kind == PH_WO) { A = (const bf16*)(ws + WS_QO); Bt = (const bf16*)(ws + WS_WO); K = D; mw = 1.0f; }
            else { A = (const bf16*)(ws + WS_GG); Bt = (const bf16*)(ws + WS_WOUT); K = DR; mw = 1.0f; }
            const float* base = (ph == 3) ? args.in[0] : X;
            pg8::Gemm g{A, Bt, M, D, K}; pg8::StaticOrder S; S.init(M, D, G, bx);
            pg8::EpiResid E{base, dry ? (float*)(ws + WS_SCR) : X, D, modl + 2 * D, NMOD, mw};
            pg8::gemm_phase<pg8::EpiResid, pg8::StaticOrder, true, true>(lds + RING_OFF, g, S, E);
        } else if (kind == PH_QKV) {
            PHASE_LOCALS
            pg8::Gemm g{XN, (const bf16*)(ws + WS_WQKV), M, NQKV, D}; pg8::StaticOrder S; S.init(M, NQKV, G, bx);
            pg8::EpiQKV E{(bf16*)(ws + WS_QO), D, D, (size_t)(WS_K - WS_QO) / 2, 0.125f * LOG2E};
            pg8::gemm_phase<pg8::EpiQKV, pg8::StaticOrder, true, true>(lds + RING_OFF, g, S, E);
        } else if (kind == PH_ATTN) {
            PHASE_LOCALS
            const sba::bf16* Qp = (const sba::bf16*)(ws + WS_QO); const sba::bf16* Kp = (const sba::bf16*)(ws + WS_K); const sba::bf16* Vp = (const sba::bf16*)(ws + WS_V);
            sba::bf16* Op = (sba::bf16*)(ws + (dry ? WS_SCR : WS_QO));
            if (G == 256) {
                const int bh = vcu >> 1, hf = vcu & 1;
                for (int i = 0; i < 4; ++i) { const int qb = (i == 0) ? 7 - hf : (i == 1) ? hf : (i == 2) ? 5 - hf : 2 + hf;
                    sba::attn_unit(bh / NH, bh % NH, qb, Qp, Kp, Vp, Op, (LAS char*)(lds + RING_OFF)); }
            } else {
                for (int it = vcu; it < BATCH * NH * 8; it += G) sba::attn_unit((it >> 3) / NH, (it >> 3) % NH, it & 7, Qp, Kp, Vp, Op, (LAS char*)(lds + RING_OFF));
            }
        } else if (kind == PH_WIN) {
            PHASE_LOCALS
            pg8::Gemm g{XN, (const bf16*)(ws + WS_WIN), M, NIN, D}; pg8::StaticOrder S; S.init(M, NIN, G, bx);
            pg8::EpiLruIn E{(bf16*)(ws + WS_GG), (float*)(ws + WS_XB), DR};
            pg8::gemm_phase<pg8::EpiLruIn, pg8::StaticOrder, true, true>(lds + RING_OFF, g, S, E);
        } else if (kind == PH_LRU1) {
            PHASE_LOCALS
            { const int upw = (1280 + G - 1) / G, id0 = vcu * upw, id1 = (id0 + upw < 1280) ? id0 + upw : 1280; lru::lru_pass<1>(args, ws, nullptr, lds, id0, id1, tid, lane, wave); }
        } else if (kind == PH_LRU2) {
            PHASE_LOCALS
            { const int upw = (1280 + G - 1) / G, id0 = vcu * upw, id1 = (id0 + upw < 1280) ? id0 + upw : 1280; lru::lru_pass<2>(args, ws, (bf16*)(ws + (dry ? WS_SCR : WS_GG)), lds, id0, id1, tid, lane, wave); }
        } else {
            PHASE_LOCALS
            final_norm_phase(X, args.in[18], dry ? (float*)(ws + WS_SCR) : X, vcu, G, lane, wave);
        }
        if (dry) xcd_barrier(bar);
        }
        if (ph + 1 < args.ph_hi) xcd_barrier(bar);
    }
}

extern "C" void kernel_launch(void* const* d_in, const int* in_sizes, int n_in, void* d_out, int out_size, void* d_ws, size_t ws_size, hipStream_t stream) {
    static int grid = 0;
    if (grid == 0) {
        if (n_in != 19 || in_sizes[0] != M * D || out_size != M * D || ws_size < WS_SCR_END) { fprintf(stderr, "kernel_launch: unexpected shapes (n_in %d, in0 %d, out %d, ws %zu); nothing launched\n", n_in, n_in > 0 ? in_sizes[0] : -1, out_size, ws_size); grid = -1; return; }
        int dev = 0, cus = 0, per_cu = 0;
        if (hipGetDevice(&dev) != hipSuccess || hipDeviceGetAttribute(&cus, hipDeviceAttributeMultiprocessorCount, dev) != hipSuccess) { fprintf(stderr, "kernel_launch: device query failed\n"); grid = -1; return; }
        if (hipFuncSetAttribute((const void*)fwd_kernel, hipFuncAttributeMaxDynamicSharedMemorySize, LDS_BYTES) != hipSuccess) { fprintf(stderr, "kernel_launch: hipFuncSetAttribute failed\n"); grid = -1; return; }
        if (hipOccupancyMaxActiveBlocksPerMultiprocessor(&per_cu, (const void*)fwd_kernel, NWAVES * 64, LDS_BYTES) != hipSuccess || per_cu < 1)
            fprintf(stderr, "kernel_launch: note: occupancy query reports %d workgroups per CU\n", per_cu);
        (void)hipGetLastError();
        grid = cus;
    }
    if (grid < 0) return;
    if (hipMemsetAsync((char*)d_ws + WS_CTL, 0, CTL_ZERO_BYTES, stream) != hipSuccess) { fprintf(stderr, "kernel_launch: hipMemsetAsync failed\n"); return; }
    Args a{};
    for (int i = 0; i < 19; ++i) a.in[i] = (const float*)d_in[i];
    a.out = (float*)d_out; a.ws = (unsigned char*)d_ws; a.dup = PROBE_DUP;
#if MK_ONE_LAUNCH
    a.ph_lo = 0; a.ph_hi = NPHASES; a.use_bar = 1;
    hipLaunchKernelGGL(fwd_kernel, dim3(grid), dim3(NWAVES * 64), LDS_BYTES, stream, a);
#else
    for (int ph = 0; ph < NPHASES; ++ph) { a.ph_lo = ph; a.ph_hi = ph + 1; a.use_bar = 0;
        hipLaunchKernelGGL(fwd_kernel, dim3(grid), dim3(NWAVES * 64), LDS_BYTES, stream, a); }
#endif
    const hipError_t le = hipPeekAtLastError();
    if (le != hipSuccess) fprintf(stderr, "kernel_launch: launch failed: %s\n", hipGetErrorName(le));
}
```
